# Optimizing an MI355X kernel written in HIP

```python
import jax, jax.numpy as jnp
from jax import lax
import numpy as np

D_MODEL = 1024
BATCH = 8
SEQ = 8192
DEPTH = 1
DEC_BATCH = 16
DEC_SEQ = 32
PAST_LEN = 2048

CHUNK = 64
SGU_CHUNK = 128
N_SGU_HEADS = 4
SGU_WIDTH = D_MODEL // 2
SGU_HEAD_DIM = SGU_WIDTH // N_SGU_HEADS
N_CONV_GROUPS = 4
CONV_WIDTH = D_MODEL // 2
CONV_K = 3
MIX_WIDTH = SGU_WIDTH + CONV_WIDTH
IN_PROJ = 2 * SGU_WIDTH + 3 * CONV_WIDTH
N_MEM = 256
N_MEM_HEADS = 4
MEM_HEAD_DIM = D_MODEL // N_MEM_HEADS
D_FF = -(-8 * D_MODEL // (3 * 256)) * 256
ALPHA = (2.0 * DEPTH) ** 0.25
BETA = (8.0 * DEPTH) ** -0.25
LN_EPS = 1e-5

kernel_name = 'hybrid_sgu_shortconv_memxattn_step'


def _layernorm(x, g, b):
    xf = x.astype(jnp.float32)
    mu = jnp.mean(xf, axis=-1, keepdims=True)
    xc = xf - mu
    var = jnp.mean(jnp.square(xc), axis=-1, keepdims=True)
    return (xc * lax.rsqrt(var + LN_EPS) * g + b).astype(x.dtype)


def _chunk_mask(n):
    idx = jnp.arange(n) // CHUNK
    return idx[None, :] <= idx[:, None]


def _sgu_prompt(u, v, w_s, b_s):
    bsz, s = v.shape[0], v.shape[1]
    n = s // SGU_CHUNK
    w = jnp.where(_chunk_mask(SGU_CHUNK)[None], w_s, 0.0).astype(v.dtype)
    vc = v.reshape(bsz, n, SGU_CHUNK, N_SGU_HEADS, SGU_HEAD_DIM)
    mixed = jnp.einsum('hij,bnjhc->bnihc', w, vc) + b_s.T[None, None, :, :, None]
    return u * mixed.reshape(u.shape)


def _sgu_sample(u, v, w_s, b_s):
    t = v.shape[1]
    w = jnp.where(_chunk_mask(t)[None], w_s[:, :t, :t], 0.0).astype(v.dtype)
    mixed = jnp.einsum('hij,bjhc->bihc', w, v) + b_s[:, :t].T[None, :, :, None]
    return u * mixed


def _layer(x, conv_prev, mem_k, mem_v, sgu_fn,
           w_in, sgu_ln_g, sgu_ln_b, w_s, b_s, w_conv, w_out, ln_mix_g, ln_mix_b,
           w_q, w_mem_o, ln_mem_g, ln_mem_b,
           w_gate, w_up, w_down, ln_ffn_g, ln_ffn_b):
    bsz, s, _ = x.shape
    z = x @ w_in
    u, v, gb, gc, xin = jnp.split(
        z, np.cumsum([SGU_WIDTH, SGU_WIDTH, CONV_WIDTH, CONV_WIDTH]).tolist(), axis=-1)
    u = u.reshape(bsz, s, N_SGU_HEADS, SGU_HEAD_DIM)
    v = _layernorm(v.reshape(bsz, s, N_SGU_HEADS, SGU_HEAD_DIM), sgu_ln_g, sgu_ln_b)
    a_out = sgu_fn(u, v, w_s, b_s).reshape(bsz, s, SGU_WIDTH)
    cx = gc * xin
    cat = jnp.concatenate([conv_prev, cx], axis=1)
    conv = (cat[:, 0:s] * w_conv[0] + cat[:, 1:s + 1] * w_conv[1]
            + cat[:, 2:s + 2] * w_conv[2])
    conv_state = cat[:, -(CONV_K - 1):]
    b_out = gb * conv
    mix = jnp.concatenate([a_out, b_out], axis=-1) @ w_out
    x = _layernorm(ALPHA * x + mix, ln_mix_g, ln_mix_b)
    q = (x @ w_q).reshape(bsz, s, N_MEM_HEADS, MEM_HEAD_DIM)
    sc = jnp.einsum('bshd,bmhd->bhsm', q, mem_k).astype(jnp.float32) * (MEM_HEAD_DIM ** -0.5)
    p = jax.nn.softmax(sc, axis=-1).astype(x.dtype)
    o = jnp.einsum('bhsm,bmhd->bshd', p, mem_v).reshape(bsz, s, D_MODEL)
    x = _layernorm(ALPHA * x + o @ w_mem_o, ln_mem_g, ln_mem_b)
    f = (jax.nn.silu(x @ w_gate) * (x @ w_up)) @ w_down
    x = _layernorm(ALPHA * x + f, ln_ffn_g, ln_ffn_b)
    return x, conv_state, v


def setup_inputs(seed: int = 0) -> dict:
    key = jax.random.key(seed)
    ks = iter(jax.random.split(key, 40))
    nrm = lambda shape, scale: jax.random.normal(next(ks), shape, jnp.float32) * scale
    gain = lambda shape: 1.0 + nrm(shape, 0.01)
    L = DEPTH
    return {
        'x_prompt': nrm((BATCH, SEQ, D_MODEL), 1.0),
        'x_sample': nrm((DEC_BATCH, DEC_SEQ, D_MODEL), 1.0),
        'cache_mem_k': nrm((L, DEC_BATCH, N_MEM, N_MEM_HEADS, MEM_HEAD_DIM), 1.0),
        'cache_mem_v': nrm((L, DEC_BATCH, N_MEM, N_MEM_HEADS, MEM_HEAD_DIM), BETA),
        'state_conv': nrm((L, DEC_BATCH, CONV_K - 1, CONV_WIDTH), 1.0),
        'mem_prompt': nrm((BATCH, N_MEM, D_MODEL), 1.0),
        'w_in': nrm((L, D_MODEL, IN_PROJ), D_MODEL ** -0.5),
        'sgu_ln_g': gain((L, N_SGU_HEADS, SGU_HEAD_DIM)),
        'sgu_ln_b': nrm((L, N_SGU_HEADS, SGU_HEAD_DIM), 0.01),
        'w_s': nrm((L, N_SGU_HEADS, SGU_CHUNK, SGU_CHUNK), SGU_CHUNK ** -0.5),
        'b_s': gain((L, N_SGU_HEADS, SGU_CHUNK)),
        'w_conv': nrm((L, CONV_K, CONV_WIDTH), CONV_K ** -0.5),
        'w_out': nrm((L, MIX_WIDTH, D_MODEL), BETA * MIX_WIDTH ** -0.5),
        'ln_mix_g': gain((L, D_MODEL)),
        'ln_mix_b': nrm((L, D_MODEL), 0.01),
        'w_q': nrm((L, D_MODEL, D_MODEL), D_MODEL ** -0.5),
        'w_mem_k': nrm((L, D_MODEL, D_MODEL), D_MODEL ** -0.5),
        'w_mem_v': nrm((L, D_MODEL, D_MODEL), BETA * D_MODEL ** -0.5),
        'w_mem_o': nrm((L, D_MODEL, D_MODEL), BETA * D_MODEL ** -0.5),
        'ln_mem_g': gain((L, D_MODEL)),
        'ln_mem_b': nrm((L, D_MODEL), 0.01),
        'w_gate': nrm((L, D_MODEL, D_FF), D_MODEL ** -0.5),
        'w_up': nrm((L, D_MODEL, D_FF), D_MODEL ** -0.5),
        'w_down': nrm((L, D_FF, D_MODEL), BETA * D_FF ** -0.5),
        'ln_ffn_g': gain((L, D_MODEL)),
        'ln_ffn_b': nrm((L, D_MODEL), 0.01),
    }


def reference(x_prompt, x_sample, cache_mem_k, cache_mem_v, state_conv, mem_prompt,
              w_in, sgu_ln_g, sgu_ln_b, w_s, b_s, w_conv, w_out, ln_mix_g, ln_mix_b,
              w_q, w_mem_k, w_mem_v, w_mem_o, ln_mem_g, ln_mem_b,
              w_gate, w_up, w_down, ln_ffn_g, ln_ffn_b):
    hp, hs = x_prompt, x_sample
    bp = x_prompt.shape[0]
    mk_p, mv_p, cv_p, cv_s, sv_s = [], [], [], [], []
    for l in range(DEPTH):
        shared = (w_in[l], sgu_ln_g[l], sgu_ln_b[l], w_s[l], b_s[l], w_conv[l], w_out[l],
                  ln_mix_g[l], ln_mix_b[l], w_q[l], w_mem_o[l], ln_mem_g[l], ln_mem_b[l],
                  w_gate[l], w_up[l], w_down[l], ln_ffn_g[l], ln_ffn_b[l])
        mk = (mem_prompt @ w_mem_k[l]).reshape(bp, N_MEM, N_MEM_HEADS, MEM_HEAD_DIM)
        mv = (mem_prompt @ w_mem_v[l]).reshape(bp, N_MEM, N_MEM_HEADS, MEM_HEAD_DIM)
        pad = jnp.zeros((bp, CONV_K - 1, CONV_WIDTH), hp.dtype)
        hp, cp, _ = _layer(hp, pad, mk, mv, _sgu_prompt, *shared)
        hs, cs, vs = _layer(hs, state_conv[l], cache_mem_k[l], cache_mem_v[l], _sgu_sample, *shared)
        mk_p.append(mk); mv_p.append(mv); cv_p.append(cp); cv_s.append(cs); sv_s.append(vs)
    mem_k_prompt = jnp.stack(mk_p)
    mem_v_prompt = jnp.stack(mv_p)
    conv_prompt = jnp.stack(cv_p)
    conv_sample = jnp.stack(cv_s)
    sgu_v_sample = jnp.stack(sv_s)
    return (hp, hs, mem_k_prompt, mem_v_prompt, conv_prompt, conv_sample, sgu_v_sample)
```

```cpp
#include <hip/hip_runtime.h>
#include <hip/hip_cooperative_groups.h>
#include <cstdio>
namespace cg = cooperative_groups;

#define LAS __attribute__((address_space(3)))
typedef unsigned short bf16_t;
typedef short bf16x8 __attribute__((ext_vector_type(8)));
typedef float f32x4 __attribute__((ext_vector_type(4)));
typedef unsigned u32x4 __attribute__((ext_vector_type(4)));
typedef unsigned u32x2 __attribute__((ext_vector_type(2)));

constexpr int TP = 65536, TS = 512, TT = TP + TS;
constexpr int DM = 1024, NZ = 2560, DFF = 2816;
constexpr float ALPHA = 1.189207115002721f;
constexpr float LN_EPS = 1e-5f;
constexpr float QSCALE = 0.0625f * 1.4426950408889634f;

constexpr size_t O_Y = 0, O_YS = 67108864, O_MK = 67633152, O_MV = 69730304, O_CP = 71827456, O_CS = 71835648, O_SV = 71852032;
constexpr size_t W_XB = 0, W_ZA = (size_t)TT * 1024 * 2, W_R2 = W_ZA + (size_t)TP * DFF * 2, W_RH = W_R2 + (size_t)TP * 1024 * 2, W_SM = W_RH + (size_t)TP * 1024 * 2;
constexpr size_t S_Z = W_SM, S_R2 = S_Z + (size_t)TS * NZ * 2, S_R3 = S_R2 + (size_t)TS * 1024 * 2, S_H = S_R3 + (size_t)TS * 1024 * 2, S_ACT = S_H + (size_t)TS * 1024 * 2, W_W = S_ACT + (size_t)TS * DFF * 2;
constexpr size_t W_WIN = W_W, W_WOUT = W_WIN + 5242880, W_WQ = W_WOUT + 2097152, W_WMO = W_WQ + 2097152, W_WMKV = W_WMO + 2097152,
                 W_WGU = W_WMKV + 4194304, W_WD = W_WGU + 11534336, W_MEMB = W_WD + 5767168, W_KB = W_MEMB + 4194304, W_VT = W_KB + 12582912,
                 W_WSB = W_VT + 12582912, W_ST = W_WSB + 131072  , W_CV = W_ST + 3 * (size_t)TT * 8  ,
                 W_WQS = W_CV + 2 * 1024 * 4 + 2 * 5632 * 4  , W_WGUS = W_WQS + 2097152, W_CNT = W_WGUS + 11534336  ,
                 W_END = W_CNT + (16 + 256 + 64) * 64;

struct Job { const float* src; bf16_t* dst; const float* rowscale; int lds_, ldd, tiles_c, tile_start, mode, pad; };
constexpr int NJOBS = 28;
struct Params {
    const float* in[26];
    float* out;
    unsigned char* ws;
    Job jobs[NJOBS];
    int total_tiles, pad;
};

__device__ __forceinline__ unsigned cvt_pk_bf16(float lo, float hi) { unsigned r; asm volatile("v_cvt_pk_bf16_f32 %0, %1, %2" : "=v"(r) : "v"(lo), "v"(hi)); return r; }
__device__ __forceinline__ float bf2f(unsigned short b) { return __uint_as_float(((unsigned)b) << 16); }
__device__ __forceinline__ float bflo(unsigned w) { return __uint_as_float(w << 16); }
__device__ __forceinline__ float bfhi(unsigned w) { return __uint_as_float(w & 0xffff0000u); }

constexpr int BM = 256, BK = 64, HALF = 128, HTB = HALF * BK * 2, STAGE_BYTES = 8 * HTB, NXCD = 8, WGM = 8;
__device__ __forceinline__ int lds_byte(int r, int c) { const int st = (r >> 4) * 2 + (c >> 5), rr = r & 15, cc = c & 31, ob = rr * 64 + cc * 2; return st * 1024 + (ob ^ (((ob >> 9) & 1) << 5)); }
__device__ __forceinline__ void stage_rc(int b, int& R, int& C) { const int st = b / 1024, sb = b % 1024, swz = sb ^ (((sb >> 9) & 1) << 5); R = (st >> 1) * 16 + swz / 64; C = (st & 1) * 32 + (swz % 64) / 2; }
__device__ __forceinline__ int perm32(int rho) { const int n = rho >> 4, i = rho & 15; return 8 * (i >> 2) + 4 * n + (i & 3); }

struct Unit { int pm, pn, kind; const char* a; const char* b; };

struct OrderMap {
    int nM, nN, nwg, G, c;
    __device__ __forceinline__ void init(int nM_, int nN_, int G_, int c_) { nM = nM_; nN = nN_; nwg = nM * nN; G = G_; c = c_; }
    __device__ __forceinline__ bool map(int L, int& pm, int& pn) const {
        if (L >= nwg) return false;
        int wgid = L; { const int q = nwg / NXCD, r = nwg % NXCD, xcd = wgid % NXCD, off = wgid / NXCD; wgid = (xcd < r ? xcd * (q + 1) : r * (q + 1) + (xcd - r) * q) + off; }
        const int nig = WGM * nN, gid = wgid / nig, fm = gid * WGM, gsz = (nM - fm) < WGM ? (nM - fm) : WGM;
        pm = fm + ((wgid % nig) % gsz); pn = (wgid % nig) / gsz; return true;
    }
};
struct OrderPlain {
    OrderMap o; const char* A; const char* B; size_t astep, bstep;
    __device__ __forceinline__ bool next(int i, Unit& u) const { if (!o.map(i * o.G + o.c, u.pm, u.pn)) return false; u.kind = 0; u.a = A + (size_t)u.pm * astep; u.b = B + (size_t)u.pn * bstep; return true; }
};
struct OrderZ {
    OrderMap o; const char* A; const char* B; const char* A2; const char* B2;
    __device__ __forceinline__ bool next(int i, Unit& u) const {
        const int L = i * o.G + o.c;
        if (o.map(L, u.pm, u.pn)) { u.kind = 0; u.a = A + (size_t)u.pm * (256 * 1024 * 2); u.b = B + (size_t)u.pn * (256 * 1024 * 2); return true; }
        const int L2 = L - o.nwg; if (L2 >= 64) return false;
        u.kind = 1; u.pm = L2 >> 3; u.pn = L2 & 7; u.a = A2 + (size_t)u.pm * (256 * 1024 * 2); u.b = B2 + (size_t)u.pn * (256 * 1024 * 2); return true;
    }
};
template <int MODE> struct OrderAttn {
    OrderMap o; const char* A; const char* B;
    __device__ __forceinline__ bool next(int i, Unit& u) const {
        if (!o.map(i * o.G + o.c, u.pm, u.pn)) return false; u.kind = 0;
        u.a = A + ((size_t)u.pm * 256 * 1024 + (size_t)u.pn * 256) * 2;
        u.b = MODE == 0 ? B + ((size_t)(u.pm >> 5) * 256 * 1024 + (size_t)u.pn * 256) * 2 : B + ((size_t)(u.pm >> 5) * 1024 + (size_t)u.pn * 256) * 256 * 2;
        return true;
    }
};

template <int N> struct OrderTeam {
    static constexpr int n = N; int nrt, w, pbase; const char* A; const char* B; size_t apanel, astep, bstep;
    __device__ __forceinline__ bool next(int i, Unit& u) const { if (i >= nrt) return false; const int L = i * 4 + w, pp = L / n, pn = L - pp * n; u.pm = pbase + pp; u.pn = pn; u.kind = 0;
        u.a = A + (size_t)u.pm * apanel + (size_t)pn * astep; u.b = B + (size_t)pn * bstep; return true; }
};
struct OrderKV {
    int G, c; const char* A2; const char* B2;
    __device__ __forceinline__ bool next(int i, Unit& u) const {
        const int L2 = i * G + c; if (L2 >= 64) return false;
        u.kind = 1; u.pm = L2 >> 3; u.pn = L2 & 7; u.a = A2 + (size_t)u.pm * (256 * 1024 * 2); u.b = B2 + (size_t)u.pn * (256 * 1024 * 2); return true;
    }
};

template <class Epi, class Sched>
__device__ __forceinline__ void gemm_phase(LAS unsigned char* lds, const int K, const int lda, const int ldb, const Sched& S, const Epi& E) {
    int tid = threadIdx.x; asm volatile("" : "+v"(tid));
    const int wid = __builtin_amdgcn_readfirstlane(tid >> 6), lane = tid & 63, wr = wid >> 2, wc = wid & 3, fr = lane & 15, fq = lane >> 4;
    const int nt = K / BK;
    unsigned voffA[2], voffB[2];
#pragma unroll
    for (int i = 0; i < 2; ++i) { int R, C; stage_rc(tid * 16 + i * 8192, R, C); const int Rb = (R & ~31) + perm32(R & 31);
        voffA[i] = (unsigned)(R * lda + C) * 2u; voffB[i] = (unsigned)(Rb * ldb + C) * 2u; }
    const size_t kstep = (size_t)(BK * 2);
    const size_t hstepA = (size_t)HALF * lda * 2, hstepB = (size_t)HALF * ldb * 2;
    const unsigned ldsw = (unsigned)wid * 1024u;
    const int aoff = lds_byte(wr * 64 + fr, fq * 8), boff = lds_byte(wc * 32 + fr, fq * 8);
#define PG8_SA(b, h) (((b) * 2 + (h)) * HTB)
#define PG8_SB(b, h) ((4 + (b) * 2 + (h)) * HTB)
#define PG8_STAGE(bufoff, gbase, voff) do { _Pragma("unroll") for (int _i = 0; _i < 2; ++_i) \
        __builtin_amdgcn_global_load_lds((const unsigned*)((const char*)(gbase) + (voff)[_i]), (LAS unsigned*)(lds + (bufoff) + ldsw + _i * 8192), 16, 0, 0); } while (0)
#define PG8_LDA(dst, b, h) do { _Pragma("unroll") for (int m = 0; m < 4; ++m) _Pragma("unroll") for (int k = 0; k < 2; ++k) dst[m][k] = *(const LAS bf16x8*)(lds + PG8_SA(b, h) + aoff + m * 2048 + k * 1024); } while (0)
#define PG8_LDB(dst, b, h) do { _Pragma("unroll") for (int n = 0; n < 2; ++n) _Pragma("unroll") for (int k = 0; k < 2; ++k) dst[n][k] = *(const LAS bf16x8*)(lds + PG8_SB(b, h) + boff + n * 2048 + k * 1024); } while (0)
#define PG8_MMA(ai, bj, At, Bt) do { __builtin_amdgcn_s_setprio(1); _Pragma("unroll") for (int m = 0; m < 4; ++m) _Pragma("unroll") for (int n = 0; n < 2; ++n) _Pragma("unroll") for (int k = 0; k < 2; ++k) \
        acc[ai][bj][m][n] = __builtin_amdgcn_mfma_f32_16x16x32_bf16(Bt[n][k], At[m][k], acc[ai][bj][m][n], 0, 0, 0); __builtin_amdgcn_s_setprio(0); } while (0)
#define PG8_WAIT_V(n) asm volatile("s_waitcnt vmcnt(" #n ")" ::: "memory")
#define PG8_WAIT_L(n) asm volatile("s_waitcnt lgkmcnt(" #n ")" ::: "memory")
#define PG8_BAR __builtin_amdgcn_s_barrier()
#define PG8_SCHED __builtin_amdgcn_sched_barrier(0)
    Unit cur, nxt; int ui = 0;
    if (!S.next(0, cur)) return;
    f32x4 acc[2][2][4][2];
#pragma unroll
    for (int a = 0; a < 2; ++a)
#pragma unroll
        for (int b = 0; b < 2; ++b)
#pragma unroll
            for (int m = 0; m < 4; ++m)
#pragma unroll
                for (int n = 0; n < 2; ++n) acc[a][b][m][n] = (f32x4){0.f, 0.f, 0.f, 0.f};
    bf16x8 At[4][2], B0[2][2], B1[2][2];
    const char* cA = cur.a; const char* cB = cur.b;
    E.prefetch(cur, lds, tid, 0);
    PG8_STAGE(PG8_SB(0, 0), cB, voffB); PG8_STAGE(PG8_SA(0, 0), cA, voffA); PG8_STAGE(PG8_SB(0, 1), cB + hstepB, voffB); PG8_STAGE(PG8_SA(0, 1), cA + hstepA, voffA);
    if (wr == 1) PG8_BAR;
    PG8_WAIT_V(4); PG8_BAR;
    PG8_STAGE(PG8_SB(1, 0), cB + kstep, voffB); PG8_STAGE(PG8_SA(1, 0), cA + kstep, voffA); PG8_STAGE(PG8_SB(1, 1), cB + hstepB + kstep, voffB);
    PG8_WAIT_V(6); PG8_BAR;
    for (;;) {
        const bool has_next = S.next(ui + 1, nxt);
        const char* nA = has_next ? nxt.a : cA; const char* nB = has_next ? nxt.b : cB;
        if (has_next) E.prefetch(nxt, lds, tid, (ui + 1) & 1);
        for (int t = 0; t < nt; t += 2) {
            const bool last = (t == nt - 2);
            const char* a1 = cA + (size_t)(t + 1) * kstep;
            const char* a2 = last ? nA : cA + (size_t)(t + 2) * kstep; const char* b2 = last ? nB : cB + (size_t)(t + 2) * kstep;
            const char* a3 = a2 + kstep; const char* b3 = b2 + kstep;
            PG8_LDB(B0, 0, 0); PG8_SCHED; PG8_LDA(At, 0, 0); PG8_STAGE(PG8_SA(1, 1), a1 + hstepA, voffA);
            PG8_WAIT_L(8); PG8_BAR; PG8_WAIT_L(0); PG8_MMA(0, 0, At, B0); PG8_BAR; PG8_SCHED;
            PG8_LDB(B1, 0, 1); PG8_STAGE(PG8_SB(0, 0), b2, voffB);
            PG8_BAR; PG8_WAIT_L(0); PG8_MMA(0, 1, At, B1); PG8_BAR;
            PG8_LDA(At, 0, 1); PG8_STAGE(PG8_SA(0, 0), a2, voffA);
            PG8_BAR; PG8_WAIT_L(0); PG8_MMA(1, 0, At, B0); PG8_BAR; PG8_SCHED;
            PG8_STAGE(PG8_SB(0, 1), b2 + hstepB, voffB);
            PG8_WAIT_V(6); PG8_BAR; PG8_MMA(1, 1, At, B1); PG8_BAR;
            PG8_LDB(B0, 1, 0); PG8_SCHED; PG8_LDA(At, 1, 0); PG8_STAGE(PG8_SA(0, 1), a2 + hstepA, voffA);
            PG8_WAIT_L(8); PG8_BAR; PG8_WAIT_L(0); PG8_MMA(0, 0, At, B0); PG8_BAR; PG8_SCHED;
            PG8_LDB(B1, 1, 1); PG8_STAGE(PG8_SB(1, 0), b3, voffB);
            PG8_BAR; PG8_WAIT_L(0); PG8_MMA(0, 1, At, B1); PG8_BAR;
            PG8_LDA(At, 1, 1); PG8_STAGE(PG8_SA(1, 0), a3, voffA);
            PG8_BAR; PG8_WAIT_L(0); PG8_MMA(1, 0, At, B0); PG8_BAR; PG8_SCHED;
            PG8_STAGE(PG8_SB(1, 1), b3 + hstepB, voffB);
            PG8_WAIT_V(6); PG8_BAR; PG8_MMA(1, 1, At, B1); PG8_BAR;
        }
        E(acc, cur, wr, wc, fr, fq, lds, ui & 1);
        if (!has_next) break;
#pragma unroll
        for (int a = 0; a < 2; ++a)
#pragma unroll
            for (int b = 0; b < 2; ++b)
#pragma unroll
                for (int m = 0; m < 4; ++m)
#pragma unroll
                    for (int n = 0; n < 2; ++n) acc[a][b][m][n] = (f32x4){0.f, 0.f, 0.f, 0.f};
        cur = nxt; cA = nA; cB = nB; ++ui;
    }
    PG8_WAIT_V(0);
    if (wr == 0) PG8_BAR;
    PG8_BAR;
#undef PG8_SA
#undef PG8_SB
#undef PG8_STAGE
#undef PG8_LDA
#undef PG8_LDB
#undef PG8_MMA
#undef PG8_WAIT_V
#undef PG8_WAIT_L
#undef PG8_SCHED
}

#define EPI_ARGS f32x4 (&acc)[2][2][4][2], const Unit& u, int wr, int wc, int fr, int fq, LAS unsigned char* lds, int pb
#define EPI_NOPF __device__ __forceinline__ void prefetch(const Unit&, LAS unsigned char*, int, int) const {}
constexpr int X_RMS = STAGE_BYTES, X_ROWS = STAGE_BYTES + 8192  , X_VEC = STAGE_BYTES + 16384  ;
#define EPI_LOOP_AM _Pragma("unroll") for (int ai = 0; ai < 2; ++ai) _Pragma("unroll") for (int m = 0; m < 4; ++m)

__device__ __forceinline__ u32x4 pack8(const f32x4 a, const f32x4 b, const float s) {
    u32x4 w; w.x = cvt_pk_bf16(a[0] * s, a[1] * s); w.y = cvt_pk_bf16(a[2] * s, a[3] * s); w.z = cvt_pk_bf16(b[0] * s, b[1] * s); w.w = cvt_pk_bf16(b[2] * s, b[3] * s); return w;
}
struct EpiBf16 {
    EPI_NOPF
    bf16_t* O; int ldc; float scale;
    __device__ __forceinline__ void operator()(EPI_ARGS) const {
        const int row0 = u.pm * BM + wr * 64 + fr, col0 = u.pn * BM + wc * 32 + 8 * fq;
        EPI_LOOP_AM { bf16_t* rowp = O + (size_t)(row0 + ai * HALF + m * 16) * ldc + col0;
#pragma unroll
            for (int bj = 0; bj < 2; ++bj) *(u32x4*)(rowp + bj * HALF) = pack8(acc[ai][bj][m][0], acc[ai][bj][m][1], scale); }
    }
};
struct EpiZ {
    EPI_NOPF
    bf16_t* Z; float* outk; float* outv; bf16_t* kb; bf16_t* vt;
    __device__ __forceinline__ void operator()(EPI_ARGS) const {
        const int row0 = u.pm * BM + wr * 64 + fr, col0 = u.pn * BM + wc * 32 + 8 * fq;
        if (u.kind == 0) {
            EPI_LOOP_AM { bf16_t* rowp = Z + (size_t)(row0 + ai * HALF + m * 16) * NZ + col0;
#pragma unroll
                for (int bj = 0; bj < 2; ++bj) *(u32x4*)(rowp + bj * HALF) = pack8(acc[ai][bj][m][0], acc[ai][bj][m][1], 1.0f); }
        } else if (u.pn < 4) {
            EPI_LOOP_AM { const size_t off = (size_t)(row0 + ai * HALF + m * 16) * 1024 + col0;
#pragma unroll
                for (int bj = 0; bj < 2; ++bj) { *(f32x4*)(outk + off + bj * HALF) = acc[ai][bj][m][0]; *(f32x4*)(outk + off + bj * HALF + 4) = acc[ai][bj][m][1];
                    *(u32x4*)(kb + off + bj * HALF) = pack8(acc[ai][bj][m][0], acc[ai][bj][m][1], 1.0f); } }
        } else {
            EPI_LOOP_AM { const int row = row0 + ai * HALF + m * 16, b = row >> 8, mm = row & 255; const size_t off = (size_t)row * 1024 + (col0 - 1024);
#pragma unroll
                for (int bj = 0; bj < 2; ++bj) { *(f32x4*)(outv + off + bj * HALF) = acc[ai][bj][m][0]; *(f32x4*)(outv + off + bj * HALF + 4) = acc[ai][bj][m][1];
                    const u32x4 w = pack8(acc[ai][bj][m][0], acc[ai][bj][m][1], 1.0f);
                    bf16_t* vp = vt + ((size_t)b * 1024 + (col0 - 1024) + bj * HALF) * 256 + mm;
                    vp[0 * 256] = (bf16_t)(w.x & 0xffff); vp[1 * 256] = (bf16_t)(w.x >> 16); vp[2 * 256] = (bf16_t)(w.y & 0xffff); vp[3 * 256] = (bf16_t)(w.y >> 16);
                    vp[4 * 256] = (bf16_t)(w.z & 0xffff); vp[5 * 256] = (bf16_t)(w.z >> 16); vp[6 * 256] = (bf16_t)(w.w & 0xffff); vp[7 * 256] = (bf16_t)(w.w >> 16); } }
        }
    }
};
__device__ __forceinline__ void row_mu_rstd(const float* st, int row, float& mu, float& rstd) {
    const float s = st[(size_t)row * 2], q = st[(size_t)row * 2 + 1]; mu = s * (1.0f / 1024.0f); rstd = rsqrtf(fmaxf(q * (1.0f / 1024.0f) - mu * mu, 0.f) + LN_EPS);
}
__device__ __forceinline__ void unpack8(const u32x4 w, f32x4& a, f32x4& b) { a = (f32x4){bflo(w.x), bfhi(w.x), bflo(w.y), bfhi(w.y)}; b = (f32x4){bflo(w.z), bfhi(w.z), bflo(w.w), bfhi(w.w)}; }
__device__ __forceinline__ void stat8(const f32x4 a, const f32x4 b, float& sm, float& sq) {
    sm = ((a[0] + a[1]) + (a[2] + a[3])) + ((b[0] + b[1]) + (b[2] + b[3]));
    sq = ((a[0] * a[0] + a[1] * a[1]) + (a[2] * a[2] + a[3] * a[3])) + ((b[0] * b[0] + b[1] * b[1]) + (b[2] * b[2] + b[3] * b[3]));
    sm += __shfl_xor(sm, 16); sm += __shfl_xor(sm, 32); sq += __shfl_xor(sq, 16); sq += __shfl_xor(sq, 32);
}
struct EpiRes1 {
    EPI_NOPF
    const float* base; bf16_t* H; float* st;
    __device__ __forceinline__ void operator()(EPI_ARGS) const {
        const int row0 = u.pm * BM + wr * 64 + fr, col0 = u.pn * BM + wc * 32 + 8 * fq;
#pragma unroll
        for (int bj = 0; bj < 2; ++bj)
#pragma unroll
            for (int ai = 0; ai < 2; ++ai) {
                f32x4 x0[4], x1[4];
#pragma unroll
                for (int m = 0; m < 4; ++m) { const size_t off = (size_t)(row0 + ai * HALF + m * 16) * 1024 + col0 + bj * HALF; x0[m] = *(const f32x4*)(base + off); x1[m] = *(const f32x4*)(base + off + 4); }
#pragma unroll
                for (int m = 0; m < 4; ++m) { const int row = row0 + ai * HALF + m * 16; const size_t off = (size_t)row * 1024 + col0 + bj * HALF;
                    const u32x4 w = pack8(x0[m] * ALPHA + acc[ai][bj][m][0], x1[m] * ALPHA + acc[ai][bj][m][1], 1.0f);
                    *(u32x4*)(H + off) = w;
                    f32x4 h0, h1; unpack8(w, h0, h1); float sm, sq; stat8(h0, h1, sm, sq);
                    if (fq == 0) { unsafeAtomicAdd(st + (size_t)row * 2, sm); unsafeAtomicAdd(st + (size_t)row * 2 + 1, sq); } }
                asm volatile("" ::: "memory"); }
    }
};
template <bool FINAL> struct EpiRes2 {
    EPI_NOPF
    bf16_t* H; float* Yout; const float* sp; const float* gp; const float* bp; float* sn;
    __device__ __forceinline__ void operator()(EPI_ARGS) const {
        const int row0 = u.pm * BM + wr * 64 + fr, col0 = u.pn * BM + wc * 32 + 8 * fq;
        typedef float f32x2 __attribute__((ext_vector_type(2)));
        float mu[2][4], rstd[2][4]; u32x4 hw[4];
#pragma unroll
        for (int m = 0; m < 4; ++m) hw[m] = *(const u32x4*)(H + (size_t)(row0 + m * 16) * 1024 + col0);
        EPI_LOOP_AM { const f32x2 t_ = *(const LAS f32x2*)(lds + X_ROWS + ((u.pm & 3) * 256 + ai * HALF + wr * 64 + m * 16 + fr) * 8); mu[ai][m] = t_.x; rstd[ai][m] = t_.y; }
#pragma unroll
        for (int bj = 0; bj < 2; ++bj) {
            const f32x4 gp0 = *(const f32x4*)(gp + col0 + bj * HALF), gp1 = *(const f32x4*)(gp + col0 + bj * HALF + 4), bp0 = *(const f32x4*)(bp + col0 + bj * HALF), bp1 = *(const f32x4*)(bp + col0 + bj * HALF + 4);
#pragma unroll
            for (int ai = 0; ai < 2; ++ai) {
                if (bj + ai > 0) {
#pragma unroll
                    for (int m = 0; m < 4; ++m) hw[m] = *(const u32x4*)(H + (size_t)(row0 + ai * HALF + m * 16) * 1024 + col0 + bj * HALF); }
#pragma unroll
                for (int m = 0; m < 4; ++m) { const int row = row0 + ai * HALF + m * 16; const size_t off = (size_t)row * 1024 + col0 + bj * HALF;
                    f32x4 a, b; unpack8(hw[m], a, b);
                    f32x4 h0 = ((a - mu[ai][m]) * rstd[ai][m] * gp0 + bp0) * ALPHA + acc[ai][bj][m][0], h1 = ((b - mu[ai][m]) * rstd[ai][m] * gp1 + bp1) * ALPHA + acc[ai][bj][m][1];
                    if (FINAL) { *(f32x4*)(Yout + off) = h0; *(f32x4*)(Yout + off + 4) = h1; }
                    else { const u32x4 w = pack8(h0, h1, 1.0f); *(u32x4*)(H + off) = w; unpack8(w, h0, h1); }
                    float sm, sq; stat8(h0, h1, sm, sq);
                    if (fq == 0) { unsafeAtomicAdd(sn + (size_t)row * 2, sm); unsafeAtomicAdd(sn + (size_t)row * 2 + 1, sq); } }
                asm volatile("" ::: "memory"); }
        }
    }
};
struct EpiFoldBf16 {
    bf16_t* O; const float* G; const float* Bc; float scale;
    __device__ __forceinline__ void prefetch(const Unit& u, LAS unsigned char* lds, int tid, int pb) const {
        const float* src = (tid < 256 ? G : Bc - 256) + u.pn * BM + tid;
        __builtin_amdgcn_global_load_lds((const unsigned*)src, (LAS unsigned*)(lds + X_VEC + pb * 2048 + (tid >> 6) * 256), 4, 0, 0);
    }
    __device__ __forceinline__ void operator()(EPI_ARGS) const {
        typedef float f32x2 __attribute__((ext_vector_type(2)));
        const int row0 = u.pm * BM + wr * 64 + fr, col0 = u.pn * BM + wc * 32 + 8 * fq;
        const LAS float* vec = (const LAS float*)(lds + X_VEC + pb * 2048) + wc * 32 + 8 * fq;
        f32x4 Gv[2][2], Bv[2][2];
#pragma unroll
        for (int bj = 0; bj < 2; ++bj)
#pragma unroll
            for (int n = 0; n < 2; ++n) { Gv[bj][n] = *(const LAS f32x4*)(vec + bj * HALF + 4 * n); Bv[bj][n] = *(const LAS f32x4*)(vec + 256 + bj * HALF + 4 * n); }
#pragma unroll
        for (int ai = 0; ai < 2; ++ai) {
#pragma unroll
            for (int m = 0; m < 4; ++m) { const int row = row0 + ai * HALF + m * 16;
                const f32x2 t_ = *(const LAS f32x2*)(lds + X_ROWS + ((u.pm & 3) * 256 + ai * HALF + wr * 64 + m * 16 + fr) * 8); const float m_ = t_.x, rs_ = t_.y;
#pragma unroll
                for (int bj = 0; bj < 2; ++bj) { const f32x4 a = (acc[ai][bj][m][0] - Gv[bj][0] * m_) * rs_ + Bv[bj][0], b = (acc[ai][bj][m][1] - Gv[bj][1] * m_) * rs_ + Bv[bj][1];
                    *(u32x4*)(O + (size_t)row * 1024 + col0 + bj * HALF) = pack8(a, b, scale); } }
            asm volatile("" ::: "memory"); }
    }
};
struct EpiSwiglu {
    bf16_t* act; const float* G; const float* Bc;
    __device__ __forceinline__ void prefetch(const Unit& u, LAS unsigned char* lds, int tid, int pb) const {
        const float* src = (tid < 256 ? G : Bc - 256) + u.pn * BM + tid;
        __builtin_amdgcn_global_load_lds((const unsigned*)src, (LAS unsigned*)(lds + X_VEC + pb * 2048 + (tid >> 6) * 256), 4, 0, 0);
    }
    __device__ __forceinline__ void operator()(EPI_ARGS) const {
        typedef float f32x2 __attribute__((ext_vector_type(2)));
        const int row0 = u.pm * BM + wr * 64 + fr, col0 = u.pn * HALF + wc * 32 + 8 * fq;
        const LAS float* vec = (const LAS float*)(lds + X_VEC + pb * 2048) + wc * 32 + 8 * fq;
        f32x4 Gg[2], Bg[2], Gu[2], Bu[2];
#pragma unroll
        for (int n = 0; n < 2; ++n) { Gg[n] = *(const LAS f32x4*)(vec + 4 * n); Bg[n] = *(const LAS f32x4*)(vec + 256 + 4 * n); Gu[n] = *(const LAS f32x4*)(vec + HALF + 4 * n); Bu[n] = *(const LAS f32x4*)(vec + 256 + HALF + 4 * n); }
#pragma unroll
        for (int ai = 0; ai < 2; ++ai) {
#pragma unroll
            for (int m = 0; m < 4; ++m) { const int row = row0 + ai * HALF + m * 16; f32x4 r[2];
                const f32x2 t_ = *(const LAS f32x2*)(lds + X_ROWS + ((u.pm & 3) * 256 + ai * HALF + wr * 64 + m * 16 + fr) * 8); const float m_ = t_.x, rs_ = t_.y;
#pragma unroll
                for (int n = 0; n < 2; ++n) { const f32x4 gv = (acc[ai][0][m][n] - Gg[n] * m_) * rs_ + Bg[n], uv = (acc[ai][1][m][n] - Gu[n] * m_) * rs_ + Bu[n];
#pragma unroll
                    for (int j = 0; j < 4; ++j) r[n][j] = gv[j] * uv[j] * __builtin_amdgcn_rcpf(1.0f + __builtin_amdgcn_exp2f(-1.4426950408889634f * gv[j])); }
                *(u32x4*)(act + (size_t)row * DFF + col0) = pack8(r[0], r[1], 1.0f); }
            asm volatile("" ::: "memory"); }
    }
};
struct EpiSoftmax {
    EPI_NOPF
    bf16_t* P;
    __device__ __forceinline__ void operator()(EPI_ARGS) const {
        typedef float f32x2 __attribute__((ext_vector_type(2)));
        LAS f32x2* RMS = (LAS f32x2*)(lds + STAGE_BYTES);
        EPI_LOOP_AM { float v = -3.0e38f;
#pragma unroll
            for (int bj = 0; bj < 2; ++bj)
#pragma unroll
                for (int n = 0; n < 2; ++n) { const f32x4 x = acc[ai][bj][m][n]; v = fmaxf(v, fmaxf(fmaxf(x[0], x[1]), fmaxf(x[2], x[3]))); }
            v = fmaxf(v, __shfl_xor(v, 16)); v = fmaxf(v, __shfl_xor(v, 32));
            float s = 0.f;
#pragma unroll
            for (int bj = 0; bj < 2; ++bj)
#pragma unroll
                for (int n = 0; n < 2; ++n) { f32x4 x = acc[ai][bj][m][n];
#pragma unroll
                    for (int j = 0; j < 4; ++j) x[j] = __builtin_amdgcn_exp2f(x[j] - v);
                    acc[ai][bj][m][n] = x; s += (x[0] + x[1]) + (x[2] + x[3]); }
            s += __shfl_xor(s, 16); s += __shfl_xor(s, 32);
            if (fq == 0) RMS[(ai * HALF + wr * 64 + m * 16 + fr) * 4 + wc] = (f32x2){v, s};
            asm volatile("" ::: "memory"); }
        asm volatile("s_waitcnt lgkmcnt(0)" ::: "memory"); __builtin_amdgcn_s_barrier(); asm volatile("" ::: "memory");
        const int row0 = u.pm * BM + wr * 64 + fr, col0 = u.pn * BM + wc * 32 + 8 * fq;
        EPI_LOOP_AM { const LAS f32x4* rp = (const LAS f32x4*)(RMS + (ai * HALF + wr * 64 + m * 16 + fr) * 4);
            const f32x4 p0 = rp[0], p1 = rp[1];
            const float M = fmaxf(fmaxf(p0[0], p0[2]), fmaxf(p1[0], p1[2]));
            const float tot = (p0[1] * __builtin_amdgcn_exp2f(p0[0] - M) + p0[3] * __builtin_amdgcn_exp2f(p0[2] - M)) + (p1[1] * __builtin_amdgcn_exp2f(p1[0] - M) + p1[3] * __builtin_amdgcn_exp2f(p1[2] - M));
            const float mo = wc == 0 ? p0[0] : (wc == 1 ? p0[2] : (wc == 2 ? p1[0] : p1[2]));
            const float inv = __builtin_amdgcn_exp2f(mo - M) / tot;
            bf16_t* rowp = P + (size_t)(row0 + ai * HALF + m * 16) * 1024 + col0;
#pragma unroll
            for (int bj = 0; bj < 2; ++bj) *(u32x4*)(rowp + bj * HALF) = pack8(acc[ai][bj][m][0], acc[ai][bj][m][1], inv);
            asm volatile("" ::: "memory"); }
    }
};

template <bool DUAL, class AP, class BP, class F>
__device__ __forceinline__ void small_gemm(LAS unsigned char* lds, const int nrt, const int ncg, const int K, const int lda, const int ldb, const AP aptr, const BP bptr, const F f) {
    int tid = threadIdx.x; asm volatile("" : "+v"(tid));
    const int lane = tid & 63, wid = __builtin_amdgcn_readfirstlane(tid >> 6), fr = lane & 15, fq = lane >> 4;
    const int grp = wid >> 2, sub = wid & 3;
    const int ntask = nrt * ncg, ksl = K >> 2;
    constexpr int NACC = DUAL ? 8 : 4;
    LAS f32x4* red = (LAS f32x4*)lds + grp * (3 * NACC * 64);
    for (int t0 = blockIdx.x * 2; t0 < ntask; t0 += gridDim.x * 2) {
        const bool act = t0 + grp < ntask; const int task = act ? t0 + grp : ntask - 1;
        const int rt = task % nrt, cg = task / nrt;
        f32x4 acc[4], acc2[4];
#pragma unroll
        for (int ct = 0; ct < 4; ++ct) { acc[ct] = (f32x4){0.f, 0.f, 0.f, 0.f}; acc2[ct] = (f32x4){0.f, 0.f, 0.f, 0.f}; }
        const bf16_t* ap = aptr(rt, cg) + (size_t)fr * lda + fq * 8 + sub * ksl;
        const bf16_t* bp[4];
#pragma unroll
        for (int ct = 0; ct < 4; ++ct) bp[ct] = bptr(rt, cg, ct) + (size_t)fr * ldb + fq * 8 + sub * ksl;
#pragma unroll 2
        for (int k0 = 0; k0 < ksl; k0 += 32) {
            const bf16x8 a = *(const bf16x8*)(ap + k0);
#pragma unroll
            for (int ct = 0; ct < 4; ++ct) { const bf16x8 b = *(const bf16x8*)(bp[ct] + k0); acc[ct] = __builtin_amdgcn_mfma_f32_16x16x32_bf16(b, a, acc[ct], 0, 0, 0);
                if (DUAL) { const bf16x8 b2 = *(const bf16x8*)(bp[ct] + (size_t)128 * ldb + k0); acc2[ct] = __builtin_amdgcn_mfma_f32_16x16x32_bf16(b2, a, acc2[ct], 0, 0, 0); } }
        }
        if (sub != 0) {
#pragma unroll
            for (int ct = 0; ct < 4; ++ct) { red[((sub - 1) * NACC + ct) * 64 + lane] = acc[ct]; if (DUAL) red[((sub - 1) * NACC + 4 + ct) * 64 + lane] = acc2[ct]; }
        }
        __syncthreads();
        if (act && sub == 0) {
#pragma unroll
            for (int w = 0; w < 3; ++w)
#pragma unroll
                for (int ct = 0; ct < 4; ++ct) { acc[ct] += red[(w * NACC + ct) * 64 + lane]; if (DUAL) acc2[ct] += red[(w * NACC + 4 + ct) * 64 + lane]; }
#pragma unroll
            for (int ct = 0; ct < 4; ++ct) f(rt * 16 + fr, cg * 64 + ct * 16 + fq * 4, acc[ct], acc2[ct]);
        }
        __syncthreads();
    }
}
__device__ __forceinline__ void colvec(const bf16_t* WS, const bf16_t* WT, int nrows, const float* b, float* G, float* Bc) {
    int tid = threadIdx.x; asm volatile("" : "+v"(tid));
    const int lane = tid & 63, wid = tid >> 6;
    for (int r = blockIdx.x * 8 + wid; r < nrows; r += gridDim.x * 8) {
        float sg = 0.f, sb = 0.f;
#pragma unroll
        for (int h = 0; h < 2; ++h) { const int k = h * 512 + lane * 8; const u32x4 w = *(const u32x4*)(WT + (size_t)r * 1024 + k), ws_ = *(const u32x4*)(WS + (size_t)r * 1024 + k);
            const f32x4 ba = *(const f32x4*)(b + k), bb = *(const f32x4*)(b + k + 4);
            sg += ((bflo(ws_.x) + bfhi(ws_.x)) + (bflo(ws_.y) + bfhi(ws_.y))) + ((bflo(ws_.z) + bfhi(ws_.z)) + (bflo(ws_.w) + bfhi(ws_.w)));
            sb += (bflo(w.x) * ba[0] + bfhi(w.x) * ba[1]) + (bflo(w.y) * ba[2] + bfhi(w.y) * ba[3]) + (bflo(w.z) * bb[0] + bfhi(w.z) * bb[1]) + (bflo(w.w) * bb[2] + bfhi(w.w) * bb[3]); }
#pragma unroll
        for (int o = 32; o >= 1; o >>= 1) { sg += __shfl_xor(sg, o); sb += __shfl_xor(sb, o); }
        if (lane == 0) { G[r] = sg; Bc[r] = sb; }
    }
}

__device__ __forceinline__ void cvt_rows(const float* src, bf16_t* dst, size_t n8, size_t t0, size_t nth) {
    size_t i = t0;
    for (; i + 3 * nth < n8; i += 4 * nth) {
        f32x4 a[4], b[4];
#pragma unroll
        for (int q = 0; q < 4; ++q) { a[q] = *(const f32x4*)(src + (i + q * nth) * 8); b[q] = *(const f32x4*)(src + (i + q * nth) * 8 + 4); }
#pragma unroll
        for (int q = 0; q < 4; ++q) *(u32x4*)(dst + (i + q * nth) * 8) = pack8(a[q], b[q], 1.0f);
    }
    for (; i < n8; i += nth) { const f32x4 a = *(const f32x4*)(src + i * 8), b = *(const f32x4*)(src + i * 8 + 4); *(u32x4*)(dst + i * 8) = pack8(a, b, 1.0f); }
}
__device__ __forceinline__ void phase_prep(const Params& p, LAS unsigned char* lds) {
    int tid = threadIdx.x; asm volatile("" : "+v"(tid));
    const size_t t0 = (size_t)blockIdx.x * 512 + tid, nth = (size_t)gridDim.x * 512;
    unsigned char* ws = p.ws;
    { unsigned* cn = (unsigned*)(ws + W_CNT); for (size_t i = t0; i < (16 + 256 + 64) * 16; i += nth) cn[i] = 0u; }
    { f32x4* st = (f32x4*)(ws + W_ST); for (size_t i = t0; i < (size_t)3 * TT * 2 / 4; i += nth) st[i] = (f32x4){0.f, 0.f, 0.f, 0.f}; }
    LAS bf16_t* tile = (LAS bf16_t*)lds;
    const int t = tid, r = t >> 3, cs = (t & 7) * 8;
    for (int tl0 = blockIdx.x * 4; tl0 < p.total_tiles; tl0 += gridDim.x * 4) {
        int j = 0;
#pragma unroll 1
        for (int k = 1; k < NJOBS; ++k) if (tl0 >= p.jobs[k].tile_start) j = k;
        const int lt0 = tl0 - p.jobs[j].tile_start, tc_n = p.jobs[j].tiles_c, mode = p.jobs[j].mode, ldsrc = p.jobs[j].lds_, ldd = p.jobs[j].ldd;
        const float* src = p.jobs[j].src; bf16_t* dst = p.jobs[j].dst; const float* rs = p.jobs[j].rowscale;
        f32x4 a[4], b[4];
#pragma unroll
        for (int q = 0; q < 4; ++q) { const int lt = lt0 + q, tr = lt / tc_n, tc = lt % tc_n;
            const float* sp = src + (size_t)(tr * 64 + r) * ldsrc + tc * 64 + cs;
            a[q] = *(const f32x4*)sp; b[q] = *(const f32x4*)(sp + 4);
            if (rs) { const float sc_ = rs[tr * 64 + r]; a[q] *= sc_; b[q] *= sc_; } }
#pragma unroll
        for (int q = 0; q < 4; ++q) *(LAS u32x4*)(tile + q * 4608 + r * 72 + cs) = pack8(a[q], b[q], 1.0f);
        __syncthreads();
#pragma unroll
        for (int q = 0; q < 4; ++q) { const int lt = lt0 + q, tr = lt / tc_n, tc = lt % tc_n;
            unsigned short e[8];
#pragma unroll
            for (int k = 0; k < 8; ++k) e[k] = tile[q * 4608 + (cs + k) * 72 + r];
            u32x4 w; w.x = e[0] | ((unsigned)e[1] << 16); w.y = e[2] | ((unsigned)e[3] << 16); w.z = e[4] | ((unsigned)e[5] << 16); w.w = e[6] | ((unsigned)e[7] << 16);
            const int sc = tc * 64 + r;
            const int drow = mode == 0 ? sc : ((sc >> 7) * 256 + (sc & 127) + (mode == 2 ? 128 : 0));
            *(u32x4*)(dst + (size_t)drow * ldd + tr * 64 + cs) = w; }
        __syncthreads();
    }
    bf16_t* xb = (bf16_t*)(ws + W_XB);
    cvt_rows(p.in[0], xb, (size_t)TP * 1024 / 8, t0, nth);
    cvt_rows(p.in[1], xb + (size_t)TP * 1024, (size_t)TS * 1024 / 8, t0, nth);
    cvt_rows(p.in[5], (bf16_t*)(ws + W_MEMB), (size_t)2048 * 1024 / 8, t0, nth);
    cvt_rows(p.in[2], (bf16_t*)(ws + W_KB) + (size_t)8 * 256 * 1024, (size_t)16 * 256 * 1024 / 8, t0, nth);
    { bf16_t* wsb = (bf16_t*)(ws + W_WSB); const float* w_s = p.in[9];
      for (size_t i = t0; i < 65536; i += nth) { const int ii = (int)((i >> 7) & 127), jj = (int)(i & 127); const float v = ((jj >> 6) <= (ii >> 6)) ? w_s[i] : 0.f; wsb[i] = (bf16_t)(cvt_pk_bf16(v, 0.f) & 0xffff); } }
}

struct SguW { const bf16_t* WSB; const float* lng; const float* lnb; const float* b_s; const float* w_conv; };
__device__ __forceinline__ void sgu_tile(LAS unsigned char* lds, const int t, const SguW& W, const bf16_t* Zt, const bf16_t* zm2, const float* st2, bf16_t* MCt, const int h, const int nvalid, float* sv_out, float* cs_out) {
    LAS bf16_t* vT = (LAS bf16_t*)lds;
    const int lane = t & 63, wid = t >> 6, fr = lane & 15, fq = lane >> 4;
    const int j = t >> 2, cseg = (t & 3) * 32;
    u32x4 vw[4];
    if (j < nvalid) {
#pragma unroll
        for (int q = 0; q < 4; ++q) vw[q] = *(const u32x4*)(Zt + (size_t)j * NZ + 512 + h * 128 + cseg + q * 8);
    }
    const int csg = t & 15, rg = t >> 4, j0 = h * 128 + csg * 8, rl0 = rg * 4;
    u32x4 gcw[6], xiw[6], gbw[4]; f32x4 sa[2][2];
    const bool cact = rl0 < nvalid;
    if (cact) {
#pragma unroll
        for (int rr = 0; rr < 6; ++rr) { const int rl = rl0 - 2 + rr;
            const bf16_t* zp = rl >= 0 ? Zt + (size_t)rl * NZ + j0 : (zm2 ? zm2 + (size_t)(rl + 2) * NZ + j0 : nullptr);
            if (zp) { gcw[rr] = *(const u32x4*)(zp + 1536); xiw[rr] = *(const u32x4*)(zp + 2048); }
            else { gcw[rr] = (u32x4){0u, 0u, 0u, 0u}; xiw[rr] = (u32x4){0u, 0u, 0u, 0u}; } }
#pragma unroll
        for (int rr = 0; rr < 4; ++rr) gbw[rr] = *(const u32x4*)(Zt + (size_t)(rl0 + rr) * NZ + 1024 + j0);
        if (st2 && rl0 == 0) {
#pragma unroll
            for (int rr = 0; rr < 2; ++rr) { sa[rr][0] = *(const f32x4*)(st2 + rr * 512 + j0); sa[rr][1] = *(const f32x4*)(st2 + rr * 512 + j0 + 4); } }
    }
    const bool mact = wid * 16 < nvalid;
    const int mi = wid * 16 + fr;
    u32x2 uw[8];
    if (mact) {
#pragma unroll
        for (int ct = 0; ct < 8; ++ct) uw[ct] = *(const u32x2*)(Zt + (size_t)mi * NZ + h * 128 + fq * 4 + ct * 16);
    }
    if (j < nvalid) {
        float v[32];
#pragma unroll
        for (int q = 0; q < 4; ++q) { const u32x4 w = vw[q];
            v[q * 8 + 0] = bflo(w.x); v[q * 8 + 1] = bfhi(w.x); v[q * 8 + 2] = bflo(w.y); v[q * 8 + 3] = bfhi(w.y); v[q * 8 + 4] = bflo(w.z); v[q * 8 + 5] = bfhi(w.z); v[q * 8 + 6] = bflo(w.w); v[q * 8 + 7] = bfhi(w.w); }
        float s = 0.f;
#pragma unroll
        for (int k = 0; k < 32; ++k) s += v[k];
        s += __shfl_xor(s, 1); s += __shfl_xor(s, 2);
        const float mu = s * (1.0f / 128.0f); float q2 = 0.f;
#pragma unroll
        for (int k = 0; k < 32; ++k) { const float d = v[k] - mu; q2 += d * d; }
        q2 += __shfl_xor(q2, 1); q2 += __shfl_xor(q2, 2);
        const float rstd = rsqrtf(q2 * (1.0f / 128.0f) + LN_EPS);
#pragma unroll
        for (int k = 0; k < 32; ++k) v[k] = (v[k] - mu) * rstd * W.lng[h * 128 + cseg + k] + W.lnb[h * 128 + cseg + k];
        if (sv_out) { float* sv = sv_out + ((size_t)j * 4 + h) * 128 + cseg;
#pragma unroll
            for (int q = 0; q < 8; ++q) *(f32x4*)(sv + q * 4) = (f32x4){v[q * 4], v[q * 4 + 1], v[q * 4 + 2], v[q * 4 + 3]}; }
#pragma unroll
        for (int k = 0; k < 32; k += 2) { const unsigned w = cvt_pk_bf16(v[k], v[k + 1]); vT[(cseg + k) * 136 + j] = (bf16_t)(w & 0xffff); vT[(cseg + k + 1) * 136 + j] = (bf16_t)(w >> 16); }
    } else {
#pragma unroll
        for (int k = 0; k < 32; ++k) vT[(cseg + k) * 136 + j] = 0;
    }
    if (cact) {
        float w0[8], w1[8], w2[8];
#pragma unroll
        for (int q = 0; q < 2; ++q) { const f32x4 a = *(const f32x4*)(W.w_conv + j0 + q * 4), b = *(const f32x4*)(W.w_conv + 512 + j0 + q * 4), c = *(const f32x4*)(W.w_conv + 1024 + j0 + q * 4);
#pragma unroll
            for (int k = 0; k < 4; ++k) { w0[q * 4 + k] = a[k]; w1[q * 4 + k] = b[k]; w2[q * 4 + k] = c[k]; } }
        float cx[6][8];
#pragma unroll
        for (int rr = 0; rr < 6; ++rr) { const u32x4 gc = gcw[rr], xi = xiw[rr];
            cx[rr][0] = bflo(gc.x) * bflo(xi.x); cx[rr][1] = bfhi(gc.x) * bfhi(xi.x); cx[rr][2] = bflo(gc.y) * bflo(xi.y); cx[rr][3] = bfhi(gc.y) * bfhi(xi.y);
            cx[rr][4] = bflo(gc.z) * bflo(xi.z); cx[rr][5] = bfhi(gc.z) * bfhi(xi.z); cx[rr][6] = bflo(gc.w) * bflo(xi.w); cx[rr][7] = bfhi(gc.w) * bfhi(xi.w); }
        if (st2 && rl0 == 0) {
#pragma unroll
            for (int rr = 0; rr < 2; ++rr)
#pragma unroll
                for (int k = 0; k < 4; ++k) { cx[rr][k] = sa[rr][0][k]; cx[rr][4 + k] = sa[rr][1][k]; } }
#pragma unroll
        for (int rr = 0; rr < 4; ++rr) { const u32x4 gb = gbw[rr];
            const float g[8] = {bflo(gb.x), bfhi(gb.x), bflo(gb.y), bfhi(gb.y), bflo(gb.z), bfhi(gb.z), bflo(gb.w), bfhi(gb.w)}; float o[8];
#pragma unroll
            for (int k = 0; k < 8; ++k) o[k] = g[k] * (cx[rr][k] * w0[k] + cx[rr + 1][k] * w1[k] + cx[rr + 2][k] * w2[k]);
            u32x4 w; w.x = cvt_pk_bf16(o[0], o[1]); w.y = cvt_pk_bf16(o[2], o[3]); w.z = cvt_pk_bf16(o[4], o[5]); w.w = cvt_pk_bf16(o[6], o[7]);
            *(u32x4*)(MCt + (size_t)(rl0 + rr) * 1024 + 512 + j0) = w; }
        if (cs_out && rl0 + 4 == nvalid) {
#pragma unroll
            for (int q = 0; q < 2; ++q) { *(f32x4*)(cs_out + j0 + q * 4) = (f32x4){cx[4][q * 4], cx[4][q * 4 + 1], cx[4][q * 4 + 2], cx[4][q * 4 + 3]};
                *(f32x4*)(cs_out + 512 + j0 + q * 4) = (f32x4){cx[5][q * 4], cx[5][q * 4 + 1], cx[5][q * 4 + 2], cx[5][q * 4 + 3]}; }
        }
    }
    __syncthreads();
    if (mact) {
        f32x4 acc[8];
#pragma unroll
        for (int ct = 0; ct < 8; ++ct) acc[ct] = (f32x4){0.f, 0.f, 0.f, 0.f};
        const int nks = (wid < 4) ? 2 : 4;
        const bf16_t* wp = W.WSB + ((size_t)h * 128 + mi) * 128 + fq * 8;
        for (int ks = 0; ks < nks; ++ks) {
            const bf16x8 a = *(const bf16x8*)(wp + ks * 32);
#pragma unroll
            for (int ct = 0; ct < 8; ++ct) { const bf16x8 b = *(const LAS bf16x8*)(vT + (ct * 16 + fr) * 136 + ks * 32 + fq * 8); acc[ct] = __builtin_amdgcn_mfma_f32_16x16x32_bf16(b, a, acc[ct], 0, 0, 0); }
        }
        const float bs = W.b_s[h * 128 + mi];
        bf16_t* op = MCt + (size_t)mi * 1024 + h * 128 + fq * 4;
#pragma unroll
        for (int ct = 0; ct < 8; ++ct) { u32x2 o; o.x = cvt_pk_bf16(bflo(uw[ct].x) * (acc[ct][0] + bs), bfhi(uw[ct].x) * (acc[ct][1] + bs)); o.y = cvt_pk_bf16(bflo(uw[ct].y) * (acc[ct][2] + bs), bfhi(uw[ct].y) * (acc[ct][3] + bs));
            *(u32x2*)(op + ct * 16) = o; }
    }
    __syncthreads();
}

__device__ __forceinline__ void ln_apply_rows(float* X, const float* st, const float* g, const float* b, const int row0, const int nrows, const int t) {
    const int cgi = t & 255, rsel = t >> 8;
    const f32x4 gv = *(const f32x4*)(g + cgi * 4), bv = *(const f32x4*)(b + cgi * 4);
    for (int r = rsel; r < nrows; r += 8) {
        f32x4 v[4]; float mu[4], rs[4];
#pragma unroll
        for (int q = 0; q < 4; ++q) { const int row = row0 + r + 2 * q; if (r + 2 * q < nrows) { v[q] = *(const f32x4*)(X + (size_t)row * 1024 + cgi * 4); row_mu_rstd(st, row, mu[q], rs[q]); } }
#pragma unroll
        for (int q = 0; q < 4; ++q) { const int row = row0 + r + 2 * q; if (r + 2 * q < nrows) *(f32x4*)(X + (size_t)row * 1024 + cgi * 4) = (v[q] - mu[q]) * rs[q] * gv + bv; }
    }
}

__device__ __forceinline__ void sample_scores(const bf16_t* Q, const bf16_t* KB, bf16_t* P, LAS unsigned char* lds) {
    typedef float f32x2 __attribute__((ext_vector_type(2)));
    int tid = threadIdx.x; asm volatile("" : "+v"(tid));
    const int lane = tid & 63, wid = tid >> 6, fr = lane & 15, fq = lane >> 4;
    if (blockIdx.x >= 128) return;
    LAS f32x2* RMS = (LAS f32x2*)lds;
    const int task = blockIdx.x, b = task >> 3, h = (task >> 1) & 3, rt = task & 1;
    const int row = b * 32 + rt * 16 + fr;
    const bf16_t* qp = Q + (size_t)row * 1024 + h * 256 + fq * 8;
    const bf16_t* kp = KB + ((size_t)(8 + b) * 256 + wid * 32 + fr) * 1024 + h * 256 + fq * 8;
    f32x4 acc[2] = {(f32x4){0.f, 0.f, 0.f, 0.f}, (f32x4){0.f, 0.f, 0.f, 0.f}};
#pragma unroll
    for (int k = 0; k < 8; ++k) { const bf16x8 qf = *(const bf16x8*)(qp + k * 32);
#pragma unroll
        for (int mt = 0; mt < 2; ++mt) { const bf16x8 kf = *(const bf16x8*)(kp + (size_t)mt * 16 * 1024 + k * 32); acc[mt] = __builtin_amdgcn_mfma_f32_16x16x32_bf16(kf, qf, acc[mt], 0, 0, 0); } }
    float mx = fmaxf(fmaxf(fmaxf(acc[0][0], acc[0][1]), fmaxf(acc[0][2], acc[0][3])), fmaxf(fmaxf(acc[1][0], acc[1][1]), fmaxf(acc[1][2], acc[1][3])));
    mx = fmaxf(mx, __shfl_xor(mx, 16)); mx = fmaxf(mx, __shfl_xor(mx, 32));
    float sm = 0.f;
#pragma unroll
    for (int mt = 0; mt < 2; ++mt)
#pragma unroll
        for (int j = 0; j < 4; ++j) { acc[mt][j] = __builtin_amdgcn_exp2f(acc[mt][j] - mx); sm += acc[mt][j]; }
    sm += __shfl_xor(sm, 16); sm += __shfl_xor(sm, 32);
    if (fq == 0) RMS[fr * 8 + wid] = (f32x2){mx, sm};
    __syncthreads();
    float M = -3.0e38f, tot = 0.f;
#pragma unroll
    for (int w = 0; w < 8; ++w) M = fmaxf(M, RMS[fr * 8 + w].x);
#pragma unroll
    for (int w = 0; w < 8; ++w) { const f32x2 v = RMS[fr * 8 + w]; tot += v.y * __builtin_amdgcn_exp2f(v.x - M); }
    const float inv = __builtin_amdgcn_exp2f(mx - M) / tot;
    bf16_t* pp = P + (size_t)row * 1024 + h * 256 + wid * 32 + fq * 4;
#pragma unroll
    for (int mt = 0; mt < 2; ++mt) { u32x2 w; w.x = cvt_pk_bf16(acc[mt][0] * inv, acc[mt][1] * inv); w.y = cvt_pk_bf16(acc[mt][2] * inv, acc[mt][3] * inv); *(u32x2*)(pp + mt * 16) = w; }
    __syncthreads();
}

#ifndef SM_WOUT
#define SM_WOUT 1
#endif
#ifndef SM_WQ
#define SM_WQ 1
#endif
#ifndef SM_WMO
#define SM_WMO 1
#endif
#ifndef SM_GU
#define SM_GU 1
#endif
#ifndef SM_DOWN
#define SM_DOWN 1
#endif
#ifndef SM_S
#define SM_S 1
#endif
#ifndef SM_PV
#define SM_PV 1
#endif
#ifndef SM_Z
#define SM_Z 1
#endif
__device__ __forceinline__ void signal_cnt(unsigned* cnt) {
    __syncthreads();
    if (threadIdx.x == 0) { __builtin_amdgcn_fence(__ATOMIC_RELEASE, "agent"); __hip_atomic_fetch_add(cnt, 1u, __ATOMIC_RELAXED, __HIP_MEMORY_SCOPE_AGENT); }
}
__device__ __forceinline__ void wait_cnt(unsigned* cnt, unsigned n) {
    if (threadIdx.x == 0) { while (__hip_atomic_load(cnt, __ATOMIC_RELAXED, __HIP_MEMORY_SCOPE_AGENT) < n) __builtin_amdgcn_s_sleep(8); }
    __syncthreads();
    __builtin_amdgcn_fence(__ATOMIC_ACQUIRE, "agent");
}
#define SG_A(base, ld) [=](int rt, int) { return (base) + (size_t)(rt * 16) * (ld); }
#define SG_B(base, ld) [=](int, int cg_, int ct) { return (base) + (size_t)(cg_ * 64 + ct * 16) * (ld); }
#define STAT_ADD(ST, row, h) do { unsafeAtomicAdd((ST) + (size_t)(row) * 2, (h[0] + h[1]) + (h[2] + h[3])); unsafeAtomicAdd((ST) + (size_t)(row) * 2 + 1, (h[0] * h[0] + h[1] * h[1]) + (h[2] * h[2] + h[3] * h[3])); } while (0)
__device__ __forceinline__ void fill_rowstats(LAS unsigned char* lds, const float* st, const int row0, const int t) {
    typedef float f32x2 __attribute__((ext_vector_type(2)));
#pragma unroll
    for (int q = 0; q < 2; ++q) { float mu, rstd; row_mu_rstd(st, row0 + t + q * 512, mu, rstd); *(LAS f32x2*)(lds + X_ROWS + (t + q * 512) * 8) = (f32x2){mu, rstd}; }
    __syncthreads();
}
__device__ __forceinline__ unsigned char* opaque_uniform(unsigned char* q) {
    unsigned lo = (unsigned)(unsigned long long)q, hi = (unsigned)((unsigned long long)q >> 32); asm volatile("" : "+v"(lo), "+v"(hi));
    lo = __builtin_amdgcn_readfirstlane(lo); hi = __builtin_amdgcn_readfirstlane(hi); return (unsigned char*)(((unsigned long long)hi << 32) | lo);
}
#define FRESH unsigned char* ws = opaque_uniform(p.ws)
#define Y (p.out)
#define XB ((bf16_t*)(ws + W_XB))
#define KB ((bf16_t*)(ws + W_KB))
#define VT ((bf16_t*)(ws + W_VT))
#define ST1 ((float*)(ws + W_ST))
#define ST2 ((float*)(ws + W_ST) + (size_t)TT * 2)
#define ST3 ((float*)(ws + W_ST) + (size_t)TT * 4)
#define GQ ((float*)(ws + W_CV))
#define BQ ((float*)(ws + W_CV) + 1024)
#define GGU ((float*)(ws + W_CV) + 2048)
#define BGU ((float*)(ws + W_CV) + 2048 + 5632)
#define g_mix (p.in[13])
#define b_mix (p.in[14])
#define g_mem (p.in[19])
#define b_mem (p.in[20])
#define CNT ((unsigned*)(ws + W_CNT))
#define ZF ((unsigned*)(ws + W_CNT) + 16 * 16)
#define sZ ((bf16_t*)(ws + S_Z))
#define sR2 ((bf16_t*)(ws + S_R2))
#define sR3 ((bf16_t*)(ws + S_R3))
#define sH ((bf16_t*)(ws + S_H))
#define sACT ((bf16_t*)(ws + S_ACT))
#define SW_INIT SguW SW; SW.WSB = (const bf16_t*)(ws + W_WSB); SW.lng = p.in[7]; SW.lnb = p.in[8]; SW.b_s = p.in[10]; SW.w_conv = p.in[11]
#define ZA ((bf16_t*)(ws + W_ZA))
#define TB ((unsigned*)(ws + W_CNT) + (16 + 256) * 16)
#define R2 ((bf16_t*)(ws + W_R2))
#define RH ((bf16_t*)(ws + W_RH))
__global__ void __launch_bounds__(512, 2) fwd_megakernel(Params p) {
    extern __shared__ __attribute__((aligned(16))) unsigned char shm[];
    LAS unsigned char* lds = (LAS unsigned char*)shm;
    cg::grid_group grid = cg::this_grid();
    const int G = (int)gridDim.x, c = (int)blockIdx.x;

    phase_prep(p, lds);
    grid.sync();
    { FRESH; OrderKV S; S.G = G; S.c = c; S.A2 = (const char*)(ws + W_MEMB); S.B2 = (const char*)(ws + W_WMKV);
      EpiZ E; E.Z = nullptr; E.outk = p.out + O_MK; E.outv = p.out + O_MV; E.kb = KB; E.vt = VT;
      gemm_phase(lds, 1024, 1024, 1024, S, E);
      const bf16_t* A = XB + (size_t)TP * 1024; const bf16_t* Bt = (const bf16_t*)(ws + W_WIN);
      small_gemm<false>(lds, 32, 40, 1024, 1024, 1024, SG_A(A, 1024), SG_B(Bt, 1024),
          [=](int r, int col, const f32x4 v, const f32x4) { u32x2 w; w.x = cvt_pk_bf16(v[0], v[1]); w.y = cvt_pk_bf16(v[2], v[3]); *(u32x2*)(sZ + (size_t)r * NZ + col) = w; });
      colvec((const bf16_t*)(ws + W_WQS), (const bf16_t*)(ws + W_WQ), 1024, b_mix, GQ, BQ);
      colvec((const bf16_t*)(ws + W_WGUS), (const bf16_t*)(ws + W_WGU), 5632, b_mem, GGU, BGU); }
    grid.sync();

    const int tx = c & 7, tw = (c >> 3) & 3, T = tx * 8 + (c >> 5), pb4 = 4 * T, bb = T >> 3;
    const int pm = pb4 + tw;
    int tid = threadIdx.x; asm volatile("" : "+v"(tid));
    int tbk = 0;
#define TEAM_BAR() do { FRESH; ++tbk; __syncthreads(); if (threadIdx.x == 0) { __builtin_amdgcn_fence(__ATOMIC_RELEASE, "agent"); unsigned* tb_ = TB + 16 * T; __hip_atomic_fetch_add(tb_, 1u, __ATOMIC_RELAXED, __HIP_MEMORY_SCOPE_AGENT); \
        while (__hip_atomic_load(tb_, __ATOMIC_RELAXED, __HIP_MEMORY_SCOPE_AGENT) < 4u * (unsigned)tbk) __builtin_amdgcn_s_sleep(2); } __syncthreads(); __builtin_amdgcn_fence(__ATOMIC_ACQUIRE, "agent"); } while (0)
    { FRESH; OrderTeam<10> S; { int n_ = 10; asm volatile("" : "+v"(n_)); S.nrt = __builtin_amdgcn_readfirstlane(n_); } S.w = tw; S.pbase = pb4; S.A = (const char*)XB; S.B = (const char*)(ws + W_WIN); S.apanel = 256 * 1024 * 2; S.astep = 0; S.bstep = 256 * 1024 * 2;
      EpiZ E; E.Z = ZA; E.outk = nullptr; E.outv = nullptr; E.kb = nullptr; E.vt = nullptr;
      if (SM_Z) gemm_phase(lds, 1024, 1024, 1024, S, E); }
    TEAM_BAR();
    if (threadIdx.x == 0) { FRESH; __hip_atomic_store(ZF + 16 * pm, 1u, __ATOMIC_RELAXED, __HIP_MEMORY_SCOPE_AGENT); }
    if (c < 64) { FRESH; SW_INIT; const int sb = c >> 2, sh = c & 3;
        sgu_tile(lds, tid, SW, sZ + (size_t)sb * 32 * NZ, nullptr, p.in[4] + (size_t)sb * 1024, sR2 + (size_t)sb * 32 * 1024, sh, 32, p.out + O_SV + (size_t)sb * 32 * 512, p.out + O_CS + (size_t)sb * 1024);
        signal_cnt(CNT + 16 * 0); }
    { FRESH; SW_INIT; const bool halo = (pm & 31) != 0;
      if (halo && tw == 0) wait_cnt(ZF + 16 * (pm - 1), 1u);
      const bf16_t* Zp = ZA + (size_t)pm * 256 * NZ; bf16_t* Mp = R2 + (size_t)pm * 256 * 1024;
      for (int tl = 0; tl < 8; ++tl) { const int blk = tl >> 2, h = tl & 3;
          const bf16_t* Zt = Zp + (size_t)blk * 128 * NZ;
          sgu_tile(lds, tid, SW, Zt, (blk || halo) ? Zt - 2 * NZ : nullptr, nullptr, Mp + (size_t)blk * 128 * 1024, h, 128, nullptr, (blk == 1 && (pm & 31) == 31) ? p.out + O_CP + (size_t)bb * 1024 : nullptr); } }
    TEAM_BAR();
    { FRESH; wait_cnt(CNT + 16 * 0, 64u);
      const bf16_t* Bt = (const bf16_t*)(ws + W_WOUT); const float* xs = p.in[1];
      small_gemm<false>(lds, 32, 16, 1024, 1024, 1024, SG_A(sR2, 1024), SG_B(Bt, 1024),
          [=](int r, int col, const f32x4 v, const f32x4) { const size_t off = (size_t)r * 1024 + col; const f32x4 hh = *(const f32x4*)(xs + off) * ALPHA + v;
              u32x2 w; w.x = cvt_pk_bf16(hh[0], hh[1]); w.y = cvt_pk_bf16(hh[2], hh[3]); *(u32x2*)(sH + off) = w; const f32x4 h = (f32x4){bflo(w.x), bfhi(w.x), bflo(w.y), bfhi(w.y)}; STAT_ADD(ST1, TP + r, h); });
      signal_cnt(CNT + 16 * 1); }
    { FRESH; OrderTeam<4> S; { int n_ = 4; asm volatile("" : "+v"(n_)); S.nrt = __builtin_amdgcn_readfirstlane(n_); } S.w = tw; S.pbase = pb4; S.A = (const char*)R2; S.B = (const char*)(ws + W_WOUT); S.apanel = 256 * 1024 * 2; S.astep = 0; S.bstep = 256 * 1024 * 2;
      EpiRes1 E; E.base = p.in[0]; E.H = RH; E.st = ST1;
      if (SM_WOUT) gemm_phase(lds, 1024, 1024, 1024, S, E); }
    TEAM_BAR();
    { FRESH; wait_cnt(CNT + 16 * 1, 256u);
      const bf16_t* Bt = (const bf16_t*)(ws + W_WQS);
      small_gemm<false>(lds, 32, 16, 1024, 1024, 1024, SG_A(sH, 1024), SG_B(Bt, 1024),
          [=](int r, int col, const f32x4 v, const f32x4) { float mu, rstd; row_mu_rstd(ST1, TP + r, mu, rstd); const f32x4 q = ((v - *(const f32x4*)(GQ + col) * mu) * rstd + *(const f32x4*)(BQ + col)) * QSCALE;
              u32x2 w; w.x = cvt_pk_bf16(q[0], q[1]); w.y = cvt_pk_bf16(q[2], q[3]); *(u32x2*)(sR2 + (size_t)r * 1024 + col) = w; });
      signal_cnt(CNT + 16 * 2); }
    { FRESH; OrderTeam<4> S; { int n_ = 4; asm volatile("" : "+v"(n_)); S.nrt = __builtin_amdgcn_readfirstlane(n_); } S.w = tw; S.pbase = pb4; S.A = (const char*)RH; S.B = (const char*)(ws + W_WQS); S.apanel = 256 * 1024 * 2; S.astep = 0; S.bstep = 256 * 1024 * 2;
      fill_rowstats(lds, ST1, pb4 * 256, tid);
      EpiFoldBf16 E; E.O = R2; E.G = GQ; E.Bc = BQ; E.scale = QSCALE;
      if (SM_WQ) gemm_phase(lds, 1024, 1024, 1024, S, E); }
    { FRESH; wait_cnt(CNT + 16 * 2, 256u);
      if (c < 128) { sample_scores(sR2, KB, sR3, lds); signal_cnt(CNT + 16 * 3); } }
    { FRESH; OrderTeam<4> S; { int n_ = 4; asm volatile("" : "+v"(n_)); S.nrt = __builtin_amdgcn_readfirstlane(n_); } S.w = tw; S.pbase = pb4; S.A = (const char*)R2; S.B = (const char*)(KB + (size_t)bb * 256 * 1024); S.apanel = 256 * 1024 * 2; S.astep = 512; S.bstep = 512;
      EpiSoftmax E; E.P = XB;
      int K_ = 256; asm volatile("" : "+v"(K_)); K_ = __builtin_amdgcn_readfirstlane(K_);
      if (SM_S) gemm_phase(lds, K_, 1024, 1024, S, E); }
    { FRESH; wait_cnt(CNT + 16 * 3, 128u);
      const bf16_t* vt = VT;
      small_gemm<false>(lds, 32, 16, 256, 1024, 256, [=](int rt, int cg_) { return sR3 + (size_t)(rt * 16) * 1024 + (cg_ >> 2) * 256; },
          [=](int rt, int cg_, int ct) { return vt + ((size_t)(8 + (rt >> 1)) * 1024 + cg_ * 64 + ct * 16) * 256; },
          [=](int r, int col, const f32x4 v, const f32x4) { u32x2 w; w.x = cvt_pk_bf16(v[0], v[1]); w.y = cvt_pk_bf16(v[2], v[3]); *(u32x2*)(sR2 + (size_t)r * 1024 + col) = w; });
      signal_cnt(CNT + 16 * 4); }
    { FRESH; OrderTeam<4> S; { int n_ = 4; asm volatile("" : "+v"(n_)); S.nrt = __builtin_amdgcn_readfirstlane(n_); } S.w = tw; S.pbase = pb4; S.A = (const char*)XB; S.B = (const char*)(VT + (size_t)bb * 1024 * 256); S.apanel = 256 * 1024 * 2; S.astep = 512; S.bstep = (size_t)256 * 256 * 2;
      EpiBf16 E; E.O = R2; E.ldc = 1024; E.scale = 1.0f;
      if (SM_PV) gemm_phase(lds, 256, 1024, 256, S, E); }
    TEAM_BAR();
    { FRESH; wait_cnt(CNT + 16 * 4, 256u);
      const bf16_t* Bt = (const bf16_t*)(ws + W_WMO);
      small_gemm<false>(lds, 32, 16, 1024, 1024, 1024, SG_A(sR2, 1024), SG_B(Bt, 1024),
          [=](int r, int col, const f32x4 v, const f32x4) { const size_t off = (size_t)r * 1024 + col; float mu, rstd; row_mu_rstd(ST1, TP + r, mu, rstd);
              const u32x2 hw = *(const u32x2*)(sH + off); const f32x4 h1 = (f32x4){bflo(hw.x), bfhi(hw.x), bflo(hw.y), bfhi(hw.y)};
              const f32x4 hh = ((h1 - mu) * rstd * *(const f32x4*)(g_mix + col) + *(const f32x4*)(b_mix + col)) * ALPHA + v;
              u32x2 w; w.x = cvt_pk_bf16(hh[0], hh[1]); w.y = cvt_pk_bf16(hh[2], hh[3]); *(u32x2*)(sH + off) = w; const f32x4 h = (f32x4){bflo(w.x), bfhi(w.x), bflo(w.y), bfhi(w.y)}; STAT_ADD(ST2, TP + r, h); });
      signal_cnt(CNT + 16 * 5); }
    { FRESH; OrderTeam<4> S; { int n_ = 4; asm volatile("" : "+v"(n_)); S.nrt = __builtin_amdgcn_readfirstlane(n_); } S.w = tw; S.pbase = pb4; S.A = (const char*)R2; S.B = (const char*)(ws + W_WMO); S.apanel = 256 * 1024 * 2; S.astep = 0; S.bstep = 256 * 1024 * 2;
      fill_rowstats(lds, ST1, pb4 * 256, tid);
      EpiRes2<false> E; E.H = RH; E.Yout = nullptr; E.sp = ST1; E.gp = g_mix; E.bp = b_mix; E.sn = ST2;
      if (SM_WMO) gemm_phase(lds, 1024, 1024, 1024, S, E); }
    TEAM_BAR();
    { FRESH; wait_cnt(CNT + 16 * 5, 256u);
      const bf16_t* Bt = (const bf16_t*)(ws + W_WGUS);
      small_gemm<true>(lds, 32, 44, 1024, 1024, 1024, SG_A(sH, 1024),
          [=](int, int cg_, int ct) { const int col = cg_ * 64 + ct * 16; return Bt + (size_t)((col >> 7) * 256 + (col & 127)) * 1024; },
          [=](int r, int col, const f32x4 ga, const f32x4 ua) { float mu, rstd; row_mu_rstd(ST2, TP + r, mu, rstd); const int gc = (col >> 7) * 256 + (col & 127);
              const f32x4 g = (ga - *(const f32x4*)(GGU + gc) * mu) * rstd + *(const f32x4*)(BGU + gc), uu = (ua - *(const f32x4*)(GGU + gc + 128) * mu) * rstd + *(const f32x4*)(BGU + gc + 128); float o[4];
#pragma unroll
              for (int j = 0; j < 4; ++j) o[j] = g[j] * uu[j] * __builtin_amdgcn_rcpf(1.0f + __builtin_amdgcn_exp2f(-1.4426950408889634f * g[j]));
              u32x2 w; w.x = cvt_pk_bf16(o[0], o[1]); w.y = cvt_pk_bf16(o[2], o[3]); *(u32x2*)(sACT + (size_t)r * DFF + col) = w; });
      signal_cnt(CNT + 16 * 6); }
    { FRESH; OrderTeam<22> S; { int n_ = 22; asm volatile("" : "+v"(n_)); S.nrt = __builtin_amdgcn_readfirstlane(n_); } S.w = tw; S.pbase = pb4; S.A = (const char*)RH; S.B = (const char*)(ws + W_WGUS); S.apanel = 256 * 1024 * 2; S.astep = 0; S.bstep = 256 * 1024 * 2;
      fill_rowstats(lds, ST2, pb4 * 256, tid);
      EpiSwiglu E; E.act = ZA; E.G = GGU; E.Bc = BGU;
      if (SM_GU) gemm_phase(lds, 1024, 1024, 1024, S, E); }
    TEAM_BAR();
    { FRESH; wait_cnt(CNT + 16 * 6, 256u);
      const bf16_t* Bt = (const bf16_t*)(ws + W_WD);
      small_gemm<false>(lds, 32, 16, DFF, DFF, DFF, SG_A(sACT, DFF), SG_B(Bt, DFF),
          [=](int r, int col, const f32x4 v, const f32x4) { const size_t off = (size_t)r * 1024 + col; float mu, rstd; row_mu_rstd(ST2, TP + r, mu, rstd);
              const u32x2 hw = *(const u32x2*)(sH + off); const f32x4 h2 = (f32x4){bflo(hw.x), bfhi(hw.x), bflo(hw.y), bfhi(hw.y)};
              const f32x4 h = ((h2 - mu) * rstd * *(const f32x4*)(g_mem + col) + *(const f32x4*)(b_mem + col)) * ALPHA + v; *(f32x4*)(Y + (size_t)TP * 1024 + off) = h; STAT_ADD(ST3, TP + r, h); });
      signal_cnt(CNT + 16 * 7); }
    { FRESH; OrderTeam<4> S; { int n_ = 4; asm volatile("" : "+v"(n_)); S.nrt = __builtin_amdgcn_readfirstlane(n_); } S.w = tw; S.pbase = pb4; S.A = (const char*)ZA; S.B = (const char*)(ws + W_WD); S.apanel = (size_t)256 * DFF * 2; S.astep = 0; S.bstep = (size_t)256 * DFF * 2;
      fill_rowstats(lds, ST2, pb4 * 256, tid);
      EpiRes2<true> E; E.H = RH; E.Yout = Y; E.sp = ST2; E.gp = g_mem; E.bp = b_mem; E.sn = ST3;
      if (SM_DOWN) gemm_phase(lds, DFF, DFF, DFF, S, E); }
    TEAM_BAR();
    { FRESH; wait_cnt(CNT + 16 * 7, 256u);
      ln_apply_rows(Y, ST3, p.in[24], p.in[25], TP + 2 * c, 2, tid); }
    { FRESH; ln_apply_rows(Y, ST3, p.in[24], p.in[25], pm * 256, 256, tid); }
}

extern "C" void kernel_launch(void* const* d_in, const int* in_sizes, int n_in, void* d_out, int out_size, void* d_ws, size_t ws_size, hipStream_t stream) {
    constexpr int LDS_BYTES = STAGE_BYTES + 20480;
    static int grid = 0;
    if (!grid) {
        int dev = 0, cus = 0, per_cu = 0;
        (void)hipGetDevice(&dev);
        (void)hipDeviceGetAttribute(&cus, hipDeviceAttributeMultiprocessorCount, dev);
        (void)hipFuncSetAttribute((const void*)fwd_megakernel, hipFuncAttributeMaxDynamicSharedMemorySize, LDS_BYTES);
        (void)hipOccupancyMaxActiveBlocksPerMultiprocessor(&per_cu, (const void*)fwd_megakernel, 512, LDS_BYTES);
        if (per_cu < 1) per_cu = 1;
        grid = cus * per_cu;
        if (ws_size < W_END) fprintf(stderr, "kernel_launch: workspace too small: %zu < %zu\n", ws_size, (size_t)W_END);
        fprintf(stderr, "kernel_launch: grid %d (cus %d x %d)%s\n", grid, cus, per_cu, grid == 256 ? "" : " -- this kernel needs exactly 256 workgroups");
    }
    Params p{};
    for (int i = 0; i < 26; ++i) p.in[i] = (const float*)d_in[i];
    p.out = (float*)d_out; p.ws = (unsigned char*)d_ws;
    unsigned char* ws = (unsigned char*)d_ws;
    int nj = 0, ts = 0;
    auto add = [&](const float* src, bf16_t* dst, int R, int C, int ldd, int mode, const float* rsc = nullptr) { Job& j = p.jobs[nj++]; j.src = src; j.dst = dst; j.rowscale = rsc; j.lds_ = C; j.ldd = ldd; j.tiles_c = C / 64; j.tile_start = ts; j.mode = mode; j.pad = 0; ts += (R / 64) * (C / 64); };
    add(p.in[6], (bf16_t*)(ws + W_WIN), 1024, 2560, 1024, 0);
    add(p.in[12], (bf16_t*)(ws + W_WOUT), 1024, 1024, 1024, 0);
    add(p.in[15], (bf16_t*)(ws + W_WQ), 1024, 1024, 1024, 0);
    add(p.in[16], (bf16_t*)(ws + W_WMKV), 1024, 1024, 1024, 0);
    add(p.in[17], (bf16_t*)(ws + W_WMKV) + (size_t)1024 * 1024, 1024, 1024, 1024, 0);
    add(p.in[18], (bf16_t*)(ws + W_WMO), 1024, 1024, 1024, 0);
    add(p.in[21], (bf16_t*)(ws + W_WGU), 1024, 2816, 1024, 1);
    add(p.in[22], (bf16_t*)(ws + W_WGU), 1024, 2816, 1024, 2);
    add(p.in[23], (bf16_t*)(ws + W_WD), 2816, 1024, 2816, 0);
    add(p.in[15], (bf16_t*)(ws + W_WQS), 1024, 1024, 1024, 0, p.in[13]);
    add(p.in[21], (bf16_t*)(ws + W_WGUS), 1024, 2816, 1024, 1, p.in[19]);
    add(p.in[22], (bf16_t*)(ws + W_WGUS), 1024, 2816, 1024, 2, p.in[19]);
    for (int b = 0; b < 16; ++b) add(p.in[3] + (size_t)b * 256 * 1024, (bf16_t*)(ws + W_VT) + (size_t)(8 + b) * 1024 * 256, 256, 1024, 256, 0);
    p.total_tiles = ts; p.pad = 0;
    void* args[] = {&p};
    hipError_t e = hipLaunchCooperativeKernel((const void*)fwd_megakernel, dim3(grid), dim3(512), args, LDS_BYTES, stream);
    if (e != hipSuccess) fprintf(stderr, "kernel_launch: cooperative launch failed: %s (grid %d)\n", hipGetErrorString(e), grid);
}
```

```cpp
#include <hip/hip_runtime.h>
#include <hip/hip_cooperative_groups.h>
#include <cstdio>
namespace cg = cooperative_groups;

#define LAS __attribute__((address_space(3)))
typedef unsigned short bf16_t;
typedef short bf16x8 __attribute__((ext_vector_type(8)));
typedef float f32x4 __attribute__((ext_vector_type(4)));
typedef unsigned u32x4 __attribute__((ext_vector_type(4)));
typedef unsigned u32x2 __attribute__((ext_vector_type(2)));

constexpr int TP = 65536, TS = 512, TT = TP + TS;
constexpr int DM = 1024, NZ = 2560, DFF = 2816;
constexpr float ALPHA = 1.189207115002721f;
constexpr float LN_EPS = 1e-5f;
constexpr float QSCALE = 0.0625f * 1.4426950408889634f;

constexpr size_t O_Y = 0, O_YS = 67108864, O_MK = 67633152, O_MV = 69730304, O_CP = 71827456, O_CS = 71835648, O_SV = 71852032;
constexpr size_t P_R1 = 0, P_R2 = 1441792, P_R3 = P_R2 + 524288, P_RH = P_R3 + 524288, PSZ = P_RH + 524288;
constexpr size_t W_XB = 0, W_PR = (size_t)TT * 1024 * 2, W_SM = W_PR + 256 * PSZ;
constexpr size_t S_Z = W_SM, S_R2 = S_Z + (size_t)TS * NZ * 2, S_R3 = S_R2 + (size_t)TS * 1024 * 2, S_H = S_R3 + (size_t)TS * 1024 * 2, S_ACT = S_H + (size_t)TS * 1024 * 2, W_W = S_ACT + (size_t)TS * DFF * 2;
constexpr size_t W_WIN = W_W, W_WOUT = W_WIN + 5242880, W_WQ = W_WOUT + 2097152, W_WMO = W_WQ + 2097152, W_WMKV = W_WMO + 2097152,
                 W_WGU = W_WMKV + 4194304, W_WD = W_WGU + 11534336, W_MEMB = W_WD + 5767168, W_KB = W_MEMB + 4194304, W_VT = W_KB + 12582912,
                 W_WSB = W_VT + 12582912, W_ST = W_WSB + 131072  , W_CV = W_ST + 3 * (size_t)TT * 8  ,
                 W_WQS = W_CV + 2 * 1024 * 4 + 2 * 5632 * 4  , W_WGUS = W_WQS + 2097152, W_CNT = W_WGUS + 11534336  ,
                 W_END = W_CNT + (16 + 256) * 64;

struct Job { const float* src; bf16_t* dst; const float* rowscale; int lds_, ldd, tiles_c, tile_start, mode, pad; };
constexpr int NJOBS = 28;
struct Params {
    const float* in[26];
    float* out;
    unsigned char* ws;
    Job jobs[NJOBS];
    int total_tiles, pad;
};

__device__ __forceinline__ unsigned cvt_pk_bf16(float lo, float hi) { unsigned r; asm volatile("v_cvt_pk_bf16_f32 %0, %1, %2" : "=v"(r) : "v"(lo), "v"(hi)); return r; }
__device__ __forceinline__ float bf2f(unsigned short b) { return __uint_as_float(((unsigned)b) << 16); }
__device__ __forceinline__ float bflo(unsigned w) { return __uint_as_float(w << 16); }
__device__ __forceinline__ float bfhi(unsigned w) { return __uint_as_float(w & 0xffff0000u); }

constexpr int BM = 256, BK = 64, HALF = 128, HTB = HALF * BK * 2, STAGE_BYTES = 8 * HTB, NXCD = 8, WGM = 8;
__device__ __forceinline__ int lds_byte(int r, int c) { const int st = (r >> 4) * 2 + (c >> 5), rr = r & 15, cc = c & 31, ob = rr * 64 + cc * 2; return st * 1024 + (ob ^ (((ob >> 9) & 1) << 5)); }
__device__ __forceinline__ void stage_rc(int b, int& R, int& C) { const int st = b / 1024, sb = b % 1024, swz = sb ^ (((sb >> 9) & 1) << 5); R = (st >> 1) * 16 + swz / 64; C = (st & 1) * 32 + (swz % 64) / 2; }
__device__ __forceinline__ int perm32(int rho) { const int n = rho >> 4, i = rho & 15; return 8 * (i >> 2) + 4 * n + (i & 3); }

struct Unit { int pm, pn, kind; const char* a; const char* b; };

struct OrderMap {
    int nM, nN, nwg, G, c;
    __device__ __forceinline__ void init(int nM_, int nN_, int G_, int c_) { nM = nM_; nN = nN_; nwg = nM * nN; G = G_; c = c_; }
    __device__ __forceinline__ bool map(int L, int& pm, int& pn) const {
        if (L >= nwg) return false;
        int wgid = L; { const int q = nwg / NXCD, r = nwg % NXCD, xcd = wgid % NXCD, off = wgid / NXCD; wgid = (xcd < r ? xcd * (q + 1) : r * (q + 1) + (xcd - r) * q) + off; }
        const int nig = WGM * nN, gid = wgid / nig, fm = gid * WGM, gsz = (nM - fm) < WGM ? (nM - fm) : WGM;
        pm = fm + ((wgid % nig) % gsz); pn = (wgid % nig) / gsz; return true;
    }
};
struct OrderPlain {
    OrderMap o; const char* A; const char* B; size_t astep, bstep;
    __device__ __forceinline__ bool next(int i, Unit& u) const { if (!o.map(i * o.G + o.c, u.pm, u.pn)) return false; u.kind = 0; u.a = A + (size_t)u.pm * astep; u.b = B + (size_t)u.pn * bstep; return true; }
};
struct OrderZ {
    OrderMap o; const char* A; const char* B; const char* A2; const char* B2;
    __device__ __forceinline__ bool next(int i, Unit& u) const {
        const int L = i * o.G + o.c;
        if (o.map(L, u.pm, u.pn)) { u.kind = 0; u.a = A + (size_t)u.pm * (256 * 1024 * 2); u.b = B + (size_t)u.pn * (256 * 1024 * 2); return true; }
        const int L2 = L - o.nwg; if (L2 >= 64) return false;
        u.kind = 1; u.pm = L2 >> 3; u.pn = L2 & 7; u.a = A2 + (size_t)u.pm * (256 * 1024 * 2); u.b = B2 + (size_t)u.pn * (256 * 1024 * 2); return true;
    }
};
template <int MODE> struct OrderAttn {
    OrderMap o; const char* A; const char* B;
    __device__ __forceinline__ bool next(int i, Unit& u) const {
        if (!o.map(i * o.G + o.c, u.pm, u.pn)) return false; u.kind = 0;
        u.a = A + ((size_t)u.pm * 256 * 1024 + (size_t)u.pn * 256) * 2;
        u.b = MODE == 0 ? B + ((size_t)(u.pm >> 5) * 256 * 1024 + (size_t)u.pn * 256) * 2 : B + ((size_t)(u.pm >> 5) * 1024 + (size_t)u.pn * 256) * 256 * 2;
        return true;
    }
};

struct OrderChain {
    int n, pm; const char* A; const char* B; size_t astep, bstep;
    __device__ __forceinline__ bool next(int i, Unit& u) const { if (i >= n) return false; u.pm = pm; u.pn = i; u.kind = 0; u.a = A + (size_t)i * astep; u.b = B + (size_t)i * bstep; return true; }
};
struct OrderKV {
    int G, c; const char* A2; const char* B2;
    __device__ __forceinline__ bool next(int i, Unit& u) const {
        const int L2 = i * G + c; if (L2 >= 64) return false;
        u.kind = 1; u.pm = L2 >> 3; u.pn = L2 & 7; u.a = A2 + (size_t)u.pm * (256 * 1024 * 2); u.b = B2 + (size_t)u.pn * (256 * 1024 * 2); return true;
    }
};

template <class Epi, class Sched>
__device__ __forceinline__ void gemm_phase(LAS unsigned char* lds, const int K, const int lda, const int ldb, const Sched& S, const Epi& E) {
    int tid = threadIdx.x; asm volatile("" : "+v"(tid));
    const int wid = __builtin_amdgcn_readfirstlane(tid >> 6), lane = tid & 63, wr = wid >> 2, wc = wid & 3, fr = lane & 15, fq = lane >> 4;
    const int nt = K / BK;
    unsigned voffA[2], voffB[2];
#pragma unroll
    for (int i = 0; i < 2; ++i) { int R, C; stage_rc(tid * 16 + i * 8192, R, C); const int Rb = (R & ~31) + perm32(R & 31);
        voffA[i] = (unsigned)(R * lda + C) * 2u; voffB[i] = (unsigned)(Rb * ldb + C) * 2u; }
    const size_t kstep = (size_t)(BK * 2);
    const size_t hstepA = (size_t)HALF * lda * 2, hstepB = (size_t)HALF * ldb * 2;
    const unsigned ldsw = (unsigned)wid * 1024u;
    const int aoff = lds_byte(wr * 64 + fr, fq * 8), boff = lds_byte(wc * 32 + fr, fq * 8);
#define PG8_SA(b, h) (((b) * 2 + (h)) * HTB)
#define PG8_SB(b, h) ((4 + (b) * 2 + (h)) * HTB)
#define PG8_STAGE(bufoff, gbase, voff) do { _Pragma("unroll") for (int _i = 0; _i < 2; ++_i) \
        __builtin_amdgcn_global_load_lds((const unsigned*)((const char*)(gbase) + (voff)[_i]), (LAS unsigned*)(lds + (bufoff) + ldsw + _i * 8192), 16, 0, 0); } while (0)
#define PG8_LDA(dst, b, h) do { _Pragma("unroll") for (int m = 0; m < 4; ++m) _Pragma("unroll") for (int k = 0; k < 2; ++k) dst[m][k] = *(const LAS bf16x8*)(lds + PG8_SA(b, h) + aoff + m * 2048 + k * 1024); } while (0)
#define PG8_LDB(dst, b, h) do { _Pragma("unroll") for (int n = 0; n < 2; ++n) _Pragma("unroll") for (int k = 0; k < 2; ++k) dst[n][k] = *(const LAS bf16x8*)(lds + PG8_SB(b, h) + boff + n * 2048 + k * 1024); } while (0)
#define PG8_MMA(ai, bj, At, Bt) do { __builtin_amdgcn_s_setprio(1); _Pragma("unroll") for (int m = 0; m < 4; ++m) _Pragma("unroll") for (int n = 0; n < 2; ++n) _Pragma("unroll") for (int k = 0; k < 2; ++k) \
        acc[ai][bj][m][n] = __builtin_amdgcn_mfma_f32_16x16x32_bf16(Bt[n][k], At[m][k], acc[ai][bj][m][n], 0, 0, 0); __builtin_amdgcn_s_setprio(0); } while (0)
#define PG8_WAIT_V(n) asm volatile("s_waitcnt vmcnt(" #n ")" ::: "memory")
#define PG8_WAIT_L(n) asm volatile("s_waitcnt lgkmcnt(" #n ")" ::: "memory")
#define PG8_BAR __builtin_amdgcn_s_barrier()
#define PG8_SCHED __builtin_amdgcn_sched_barrier(0)
    Unit cur, nxt; int ui = 0;
    if (!S.next(0, cur)) return;
    f32x4 acc[2][2][4][2];
#pragma unroll
    for (int a = 0; a < 2; ++a)
#pragma unroll
        for (int b = 0; b < 2; ++b)
#pragma unroll
            for (int m = 0; m < 4; ++m)
#pragma unroll
                for (int n = 0; n < 2; ++n) acc[a][b][m][n] = (f32x4){0.f, 0.f, 0.f, 0.f};
    bf16x8 At[4][2], B0[2][2], B1[2][2];
    const char* cA = cur.a; const char* cB = cur.b;
    E.prefetch(cur, lds, tid, 0);
    PG8_STAGE(PG8_SB(0, 0), cB, voffB); PG8_STAGE(PG8_SA(0, 0), cA, voffA); PG8_STAGE(PG8_SB(0, 1), cB + hstepB, voffB); PG8_STAGE(PG8_SA(0, 1), cA + hstepA, voffA);
    if (wr == 1) PG8_BAR;
    PG8_WAIT_V(4); PG8_BAR;
    PG8_STAGE(PG8_SB(1, 0), cB + kstep, voffB); PG8_STAGE(PG8_SA(1, 0), cA + kstep, voffA); PG8_STAGE(PG8_SB(1, 1), cB + hstepB + kstep, voffB);
    PG8_WAIT_V(6); PG8_BAR;
    for (;;) {
        const bool has_next = S.next(ui + 1, nxt);
        const char* nA = has_next ? nxt.a : cA; const char* nB = has_next ? nxt.b : cB;
        if (has_next) E.prefetch(nxt, lds, tid, (ui + 1) & 1);
        for (int t = 0; t < nt; t += 2) {
            const bool last = (t == nt - 2);
            const char* a1 = cA + (size_t)(t + 1) * kstep;
            const char* a2 = last ? nA : cA + (size_t)(t + 2) * kstep; const char* b2 = last ? nB : cB + (size_t)(t + 2) * kstep;
            const char* a3 = a2 + kstep; const char* b3 = b2 + kstep;
            PG8_LDB(B0, 0, 0); PG8_SCHED; PG8_LDA(At, 0, 0); PG8_STAGE(PG8_SA(1, 1), a1 + hstepA, voffA);
            PG8_WAIT_L(8); PG8_BAR; PG8_WAIT_L(0); PG8_MMA(0, 0, At, B0); PG8_BAR; PG8_SCHED;
            PG8_LDB(B1, 0, 1); PG8_STAGE(PG8_SB(0, 0), b2, voffB);
            PG8_BAR; PG8_WAIT_L(0); PG8_MMA(0, 1, At, B1); PG8_BAR;
            PG8_LDA(At, 0, 1); PG8_STAGE(PG8_SA(0, 0), a2, voffA);
            PG8_BAR; PG8_WAIT_L(0); PG8_MMA(1, 0, At, B0); PG8_BAR; PG8_SCHED;
            PG8_STAGE(PG8_SB(0, 1), b2 + hstepB, voffB);
            PG8_WAIT_V(6); PG8_BAR; PG8_MMA(1, 1, At, B1); PG8_BAR;
            PG8_LDB(B0, 1, 0); PG8_SCHED; PG8_LDA(At, 1, 0); PG8_STAGE(PG8_SA(0, 1), a2 + hstepA, voffA);
            PG8_WAIT_L(8); PG8_BAR; PG8_WAIT_L(0); PG8_MMA(0, 0, At, B0); PG8_BAR; PG8_SCHED;
            PG8_LDB(B1, 1, 1); PG8_STAGE(PG8_SB(1, 0), b3, voffB);
            PG8_BAR; PG8_WAIT_L(0); PG8_MMA(0, 1, At, B1); PG8_BAR;
            PG8_LDA(At, 1, 1); PG8_STAGE(PG8_SA(1, 0), a3, voffA);
            PG8_BAR; PG8_WAIT_L(0); PG8_MMA(1, 0, At, B0); PG8_BAR; PG8_SCHED;
            PG8_STAGE(PG8_SB(1, 1), b3 + hstepB, voffB);
            PG8_WAIT_V(6); PG8_BAR; PG8_MMA(1, 1, At, B1); PG8_BAR;
        }
        E(acc, cur, wr, wc, fr, fq, lds, ui & 1);
        if (!has_next) break;
#pragma unroll
        for (int a = 0; a < 2; ++a)
#pragma unroll
            for (int b = 0; b < 2; ++b)
#pragma unroll
                for (int m = 0; m < 4; ++m)
#pragma unroll
                    for (int n = 0; n < 2; ++n) acc[a][b][m][n] = (f32x4){0.f, 0.f, 0.f, 0.f};
        cur = nxt; cA = nA; cB = nB; ++ui;
    }
    PG8_WAIT_V(0);
    if (wr == 0) PG8_BAR;
    PG8_BAR;
#undef PG8_SA
#undef PG8_SB
#undef PG8_STAGE
#undef PG8_LDA
#undef PG8_LDB
#undef PG8_MMA
#undef PG8_WAIT_V
#undef PG8_WAIT_L
#undef PG8_SCHED
}

#define EPI_ARGS f32x4 (&acc)[2][2][4][2], const Unit& u, int wr, int wc, int fr, int fq, LAS unsigned char* lds, int pb
#define EPI_NOPF __device__ __forceinline__ void prefetch(const Unit&, LAS unsigned char*, int, int) const {}
constexpr int X_RMS = STAGE_BYTES, X_ROWS = STAGE_BYTES + 8192  , X_VEC = STAGE_BYTES + 10240  ;
#define EPI_LOOP_AM _Pragma("unroll") for (int ai = 0; ai < 2; ++ai) _Pragma("unroll") for (int m = 0; m < 4; ++m)

__device__ __forceinline__ u32x4 pack8(const f32x4 a, const f32x4 b, const float s) {
    u32x4 w; w.x = cvt_pk_bf16(a[0] * s, a[1] * s); w.y = cvt_pk_bf16(a[2] * s, a[3] * s); w.z = cvt_pk_bf16(b[0] * s, b[1] * s); w.w = cvt_pk_bf16(b[2] * s, b[3] * s); return w;
}
struct EpiBf16 {
    EPI_NOPF
    bf16_t* O; int ldc; float scale;
    __device__ __forceinline__ void operator()(EPI_ARGS) const {
        const int row0 = u.pm * BM + wr * 64 + fr, col0 = u.pn * BM + wc * 32 + 8 * fq;
        EPI_LOOP_AM { bf16_t* rowp = O + (size_t)(row0 + ai * HALF + m * 16) * ldc + col0;
#pragma unroll
            for (int bj = 0; bj < 2; ++bj) *(u32x4*)(rowp + bj * HALF) = pack8(acc[ai][bj][m][0], acc[ai][bj][m][1], scale); }
    }
};
struct EpiZ {
    EPI_NOPF
    bf16_t* Z; float* outk; float* outv; bf16_t* kb; bf16_t* vt;
    __device__ __forceinline__ void operator()(EPI_ARGS) const {
        const int row0 = u.pm * BM + wr * 64 + fr, col0 = u.pn * BM + wc * 32 + 8 * fq;
        if (u.kind == 0) {
            EPI_LOOP_AM { bf16_t* rowp = Z + (size_t)(row0 + ai * HALF + m * 16) * NZ + col0;
#pragma unroll
                for (int bj = 0; bj < 2; ++bj) __builtin_nontemporal_store(pack8(acc[ai][bj][m][0], acc[ai][bj][m][1], 1.0f), (u32x4*)(rowp + bj * HALF)); }
        } else if (u.pn < 4) {
            EPI_LOOP_AM { const size_t off = (size_t)(row0 + ai * HALF + m * 16) * 1024 + col0;
#pragma unroll
                for (int bj = 0; bj < 2; ++bj) { *(f32x4*)(outk + off + bj * HALF) = acc[ai][bj][m][0]; *(f32x4*)(outk + off + bj * HALF + 4) = acc[ai][bj][m][1];
                    *(u32x4*)(kb + off + bj * HALF) = pack8(acc[ai][bj][m][0], acc[ai][bj][m][1], 1.0f); } }
        } else {
            EPI_LOOP_AM { const int row = row0 + ai * HALF + m * 16, b = row >> 8, mm = row & 255; const size_t off = (size_t)row * 1024 + (col0 - 1024);
#pragma unroll
                for (int bj = 0; bj < 2; ++bj) { *(f32x4*)(outv + off + bj * HALF) = acc[ai][bj][m][0]; *(f32x4*)(outv + off + bj * HALF + 4) = acc[ai][bj][m][1];
                    const u32x4 w = pack8(acc[ai][bj][m][0], acc[ai][bj][m][1], 1.0f);
                    bf16_t* vp = vt + ((size_t)b * 1024 + (col0 - 1024) + bj * HALF) * 256 + mm;
                    vp[0 * 256] = (bf16_t)(w.x & 0xffff); vp[1 * 256] = (bf16_t)(w.x >> 16); vp[2 * 256] = (bf16_t)(w.y & 0xffff); vp[3 * 256] = (bf16_t)(w.y >> 16);
                    vp[4 * 256] = (bf16_t)(w.z & 0xffff); vp[5 * 256] = (bf16_t)(w.z >> 16); vp[6 * 256] = (bf16_t)(w.w & 0xffff); vp[7 * 256] = (bf16_t)(w.w >> 16); } }
        }
    }
};
__device__ __forceinline__ void row_mu_rstd(const float* st, int row, float& mu, float& rstd) {
    const float s = st[(size_t)row * 2], q = st[(size_t)row * 2 + 1]; mu = s * (1.0f / 1024.0f); rstd = rsqrtf(fmaxf(q * (1.0f / 1024.0f) - mu * mu, 0.f) + LN_EPS);
}
__device__ __forceinline__ void unpack8(const u32x4 w, f32x4& a, f32x4& b) { a = (f32x4){bflo(w.x), bfhi(w.x), bflo(w.y), bfhi(w.y)}; b = (f32x4){bflo(w.z), bfhi(w.z), bflo(w.w), bfhi(w.w)}; }
__device__ __forceinline__ void stat8(const f32x4 a, const f32x4 b, float& sm, float& sq) {
    sm = ((a[0] + a[1]) + (a[2] + a[3])) + ((b[0] + b[1]) + (b[2] + b[3]));
    sq = ((a[0] * a[0] + a[1] * a[1]) + (a[2] * a[2] + a[3] * a[3])) + ((b[0] * b[0] + b[1] * b[1]) + (b[2] * b[2] + b[3] * b[3]));
    sm += __shfl_xor(sm, 16); sm += __shfl_xor(sm, 32); sq += __shfl_xor(sq, 16); sq += __shfl_xor(sq, 32);
}
struct EpiRes1 {
    EPI_NOPF
    const float* base; bf16_t* H; float* st;
    __device__ __forceinline__ void operator()(EPI_ARGS) const {
        const int row0 = u.pm * BM + wr * 64 + fr, col0 = u.pn * BM + wc * 32 + 8 * fq;
#pragma unroll
        for (int bj = 0; bj < 2; ++bj)
#pragma unroll
            for (int ai = 0; ai < 2; ++ai) {
                f32x4 x0[4], x1[4];
#pragma unroll
                for (int m = 0; m < 4; ++m) { const size_t off = (size_t)(row0 + ai * HALF + m * 16) * 1024 + col0 + bj * HALF; x0[m] = *(const f32x4*)(base + off); x1[m] = *(const f32x4*)(base + off + 4); }
#pragma unroll
                for (int m = 0; m < 4; ++m) { const int row = row0 + ai * HALF + m * 16; const size_t off = (size_t)row * 1024 + col0 + bj * HALF;
                    const u32x4 w = pack8(x0[m] * ALPHA + acc[ai][bj][m][0], x1[m] * ALPHA + acc[ai][bj][m][1], 1.0f);
                    *(u32x4*)(H + off) = w;
                    f32x4 h0, h1; unpack8(w, h0, h1); float sm, sq; stat8(h0, h1, sm, sq);
                    if (fq == 0) { unsafeAtomicAdd(st + (size_t)row * 2, sm); unsafeAtomicAdd(st + (size_t)row * 2 + 1, sq); } }
                asm volatile("" ::: "memory"); }
    }
};
template <bool FINAL> struct EpiRes2 {
    EPI_NOPF
    bf16_t* H; float* Yout; const float* sp; const float* gp; const float* bp; float* sn;
    __device__ __forceinline__ void operator()(EPI_ARGS) const {
        const int row0 = u.pm * BM + wr * 64 + fr, col0 = u.pn * BM + wc * 32 + 8 * fq;
        typedef float f32x2 __attribute__((ext_vector_type(2)));
        float mu[2][4], rstd[2][4]; u32x4 hw[4];
#pragma unroll
        for (int m = 0; m < 4; ++m) hw[m] = *(const u32x4*)(H + (size_t)(row0 + m * 16) * 1024 + col0);
        EPI_LOOP_AM { const f32x2 t_ = *(const LAS f32x2*)(lds + X_ROWS + (ai * HALF + wr * 64 + m * 16 + fr) * 8); mu[ai][m] = t_.x; rstd[ai][m] = t_.y; }
#pragma unroll
        for (int bj = 0; bj < 2; ++bj) {
            const f32x4 gp0 = *(const f32x4*)(gp + col0 + bj * HALF), gp1 = *(const f32x4*)(gp + col0 + bj * HALF + 4), bp0 = *(const f32x4*)(bp + col0 + bj * HALF), bp1 = *(const f32x4*)(bp + col0 + bj * HALF + 4);
#pragma unroll
            for (int ai = 0; ai < 2; ++ai) {
                if (bj + ai > 0) {
#pragma unroll
                    for (int m = 0; m < 4; ++m) hw[m] = *(const u32x4*)(H + (size_t)(row0 + ai * HALF + m * 16) * 1024 + col0 + bj * HALF); }
#pragma unroll
                for (int m = 0; m < 4; ++m) { const int row = row0 + ai * HALF + m * 16; const size_t off = (size_t)row * 1024 + col0 + bj * HALF;
                    f32x4 a, b; unpack8(hw[m], a, b);
                    f32x4 h0 = ((a - mu[ai][m]) * rstd[ai][m] * gp0 + bp0) * ALPHA + acc[ai][bj][m][0], h1 = ((b - mu[ai][m]) * rstd[ai][m] * gp1 + bp1) * ALPHA + acc[ai][bj][m][1];
                    if (FINAL) { *(f32x4*)(Yout + off) = h0; *(f32x4*)(Yout + off + 4) = h1; }
                    else { const u32x4 w = pack8(h0, h1, 1.0f); *(u32x4*)(H + off) = w; unpack8(w, h0, h1); }
                    float sm, sq; stat8(h0, h1, sm, sq);
                    if (fq == 0) { unsafeAtomicAdd(sn + (size_t)row * 2, sm); unsafeAtomicAdd(sn + (size_t)row * 2 + 1, sq); } }
                asm volatile("" ::: "memory"); }
        }
    }
};
struct EpiFoldBf16 {
    bf16_t* O; const float* G; const float* Bc; float scale;
    __device__ __forceinline__ void prefetch(const Unit& u, LAS unsigned char* lds, int tid, int pb) const {
        const float* src = (tid < 256 ? G : Bc - 256) + u.pn * BM + tid;
        __builtin_amdgcn_global_load_lds((const unsigned*)src, (LAS unsigned*)(lds + X_VEC + pb * 2048 + (tid >> 6) * 256), 4, 0, 0);
    }
    __device__ __forceinline__ void operator()(EPI_ARGS) const {
        typedef float f32x2 __attribute__((ext_vector_type(2)));
        const int row0 = u.pm * BM + wr * 64 + fr, col0 = u.pn * BM + wc * 32 + 8 * fq;
        const LAS float* vec = (const LAS float*)(lds + X_VEC + pb * 2048) + wc * 32 + 8 * fq;
        f32x4 Gv[2][2], Bv[2][2];
#pragma unroll
        for (int bj = 0; bj < 2; ++bj)
#pragma unroll
            for (int n = 0; n < 2; ++n) { Gv[bj][n] = *(const LAS f32x4*)(vec + bj * HALF + 4 * n); Bv[bj][n] = *(const LAS f32x4*)(vec + 256 + bj * HALF + 4 * n); }
#pragma unroll
        for (int ai = 0; ai < 2; ++ai) {
#pragma unroll
            for (int m = 0; m < 4; ++m) { const int row = row0 + ai * HALF + m * 16;
                const f32x2 t_ = *(const LAS f32x2*)(lds + X_ROWS + (ai * HALF + wr * 64 + m * 16 + fr) * 8); const float m_ = t_.x, rs_ = t_.y;
#pragma unroll
                for (int bj = 0; bj < 2; ++bj) { const f32x4 a = (acc[ai][bj][m][0] - Gv[bj][0] * m_) * rs_ + Bv[bj][0], b = (acc[ai][bj][m][1] - Gv[bj][1] * m_) * rs_ + Bv[bj][1];
                    *(u32x4*)(O + (size_t)row * 1024 + col0 + bj * HALF) = pack8(a, b, scale); } }
            asm volatile("" ::: "memory"); }
    }
};
struct EpiSwiglu {
    bf16_t* act; const float* G; const float* Bc;
    __device__ __forceinline__ void prefetch(const Unit& u, LAS unsigned char* lds, int tid, int pb) const {
        const float* src = (tid < 256 ? G : Bc - 256) + u.pn * BM + tid;
        __builtin_amdgcn_global_load_lds((const unsigned*)src, (LAS unsigned*)(lds + X_VEC + pb * 2048 + (tid >> 6) * 256), 4, 0, 0);
    }
    __device__ __forceinline__ void operator()(EPI_ARGS) const {
        typedef float f32x2 __attribute__((ext_vector_type(2)));
        const int row0 = u.pm * BM + wr * 64 + fr, col0 = u.pn * HALF + wc * 32 + 8 * fq;
        const LAS float* vec = (const LAS float*)(lds + X_VEC + pb * 2048) + wc * 32 + 8 * fq;
        f32x4 Gg[2], Bg[2], Gu[2], Bu[2];
#pragma unroll
        for (int n = 0; n < 2; ++n) { Gg[n] = *(const LAS f32x4*)(vec + 4 * n); Bg[n] = *(const LAS f32x4*)(vec + 256 + 4 * n); Gu[n] = *(const LAS f32x4*)(vec + HALF + 4 * n); Bu[n] = *(const LAS f32x4*)(vec + 256 + HALF + 4 * n); }
#pragma unroll
        for (int ai = 0; ai < 2; ++ai) {
#pragma unroll
            for (int m = 0; m < 4; ++m) { const int row = row0 + ai * HALF + m * 16; f32x4 r[2];
                const f32x2 t_ = *(const LAS f32x2*)(lds + X_ROWS + (ai * HALF + wr * 64 + m * 16 + fr) * 8); const float m_ = t_.x, rs_ = t_.y;
#pragma unroll
                for (int n = 0; n < 2; ++n) { const f32x4 gv = (acc[ai][0][m][n] - Gg[n] * m_) * rs_ + Bg[n], uv = (acc[ai][1][m][n] - Gu[n] * m_) * rs_ + Bu[n];
#pragma unroll
                    for (int j = 0; j < 4; ++j) r[n][j] = gv[j] * uv[j] * __builtin_amdgcn_rcpf(1.0f + __builtin_amdgcn_exp2f(-1.4426950408889634f * gv[j])); }
                __builtin_nontemporal_store(pack8(r[0], r[1], 1.0f), (u32x4*)(act + (size_t)row * DFF + col0)); }
            asm volatile("" ::: "memory"); }
    }
};
struct EpiSoftmax {
    EPI_NOPF
    bf16_t* P;
    __device__ __forceinline__ void operator()(EPI_ARGS) const {
        typedef float f32x2 __attribute__((ext_vector_type(2)));
        LAS f32x2* RMS = (LAS f32x2*)(lds + STAGE_BYTES);
        EPI_LOOP_AM { float v = -3.0e38f;
#pragma unroll
            for (int bj = 0; bj < 2; ++bj)
#pragma unroll
                for (int n = 0; n < 2; ++n) { const f32x4 x = acc[ai][bj][m][n]; v = fmaxf(v, fmaxf(fmaxf(x[0], x[1]), fmaxf(x[2], x[3]))); }
            v = fmaxf(v, __shfl_xor(v, 16)); v = fmaxf(v, __shfl_xor(v, 32));
            float s = 0.f;
#pragma unroll
            for (int bj = 0; bj < 2; ++bj)
#pragma unroll
                for (int n = 0; n < 2; ++n) { f32x4 x = acc[ai][bj][m][n];
#pragma unroll
                    for (int j = 0; j < 4; ++j) x[j] = __builtin_amdgcn_exp2f(x[j] - v);
                    acc[ai][bj][m][n] = x; s += (x[0] + x[1]) + (x[2] + x[3]); }
            s += __shfl_xor(s, 16); s += __shfl_xor(s, 32);
            if (fq == 0) RMS[(ai * HALF + wr * 64 + m * 16 + fr) * 4 + wc] = (f32x2){v, s};
            asm volatile("" ::: "memory"); }
        asm volatile("s_waitcnt lgkmcnt(0)" ::: "memory"); __builtin_amdgcn_s_barrier(); asm volatile("" ::: "memory");
        const int row0 = u.pm * BM + wr * 64 + fr, col0 = u.pn * BM + wc * 32 + 8 * fq;
        EPI_LOOP_AM { const LAS f32x4* rp = (const LAS f32x4*)(RMS + (ai * HALF + wr * 64 + m * 16 + fr) * 4);
            const f32x4 p0 = rp[0], p1 = rp[1];
            const float M = fmaxf(fmaxf(p0[0], p0[2]), fmaxf(p1[0], p1[2]));
            const float tot = (p0[1] * __builtin_amdgcn_exp2f(p0[0] - M) + p0[3] * __builtin_amdgcn_exp2f(p0[2] - M)) + (p1[1] * __builtin_amdgcn_exp2f(p1[0] - M) + p1[3] * __builtin_amdgcn_exp2f(p1[2] - M));
            const float mo = wc == 0 ? p0[0] : (wc == 1 ? p0[2] : (wc == 2 ? p1[0] : p1[2]));
            const float inv = __builtin_amdgcn_exp2f(mo - M) / tot;
            bf16_t* rowp = P + (size_t)(row0 + ai * HALF + m * 16) * 1024 + col0;
#pragma unroll
            for (int bj = 0; bj < 2; ++bj) *(u32x4*)(rowp + bj * HALF) = pack8(acc[ai][bj][m][0], acc[ai][bj][m][1], inv);
            asm volatile("" ::: "memory"); }
    }
};

template <bool DUAL, class AP, class BP, class F>
__device__ __forceinline__ void small_gemm(LAS unsigned char* lds, const int nrt, const int ncg, const int K, const int lda, const int ldb, const AP aptr, const BP bptr, const F f) {
    int tid = threadIdx.x; asm volatile("" : "+v"(tid));
    const int lane = tid & 63, wid = __builtin_amdgcn_readfirstlane(tid >> 6), fr = lane & 15, fq = lane >> 4;
    const int ntask = nrt * ncg, ksl = K >> 3;
    LAS f32x4* red = (LAS f32x4*)lds;
    constexpr int NACC = DUAL ? 8 : 4;
    for (int task = blockIdx.x; task < ntask; task += gridDim.x) {
        const int rt = task % nrt, cg = task / nrt;
        const bf16_t* ap = aptr(rt, cg) + (size_t)fr * lda + fq * 8 + wid * ksl;
        const bf16_t* bp[4];
#pragma unroll
        for (int ct = 0; ct < 4; ++ct) bp[ct] = bptr(rt, cg, ct) + (size_t)fr * ldb + fq * 8 + wid * ksl;
        f32x4 acc[4], acc2[4];
#pragma unroll
        for (int ct = 0; ct < 4; ++ct) { acc[ct] = (f32x4){0.f, 0.f, 0.f, 0.f}; acc2[ct] = (f32x4){0.f, 0.f, 0.f, 0.f}; }
#pragma unroll 2
        for (int k0 = 0; k0 < ksl; k0 += 32) {
            const bf16x8 a = *(const bf16x8*)(ap + k0);
#pragma unroll
            for (int ct = 0; ct < 4; ++ct) { const bf16x8 b = *(const bf16x8*)(bp[ct] + k0); acc[ct] = __builtin_amdgcn_mfma_f32_16x16x32_bf16(b, a, acc[ct], 0, 0, 0);
                if (DUAL) { const bf16x8 b2 = *(const bf16x8*)(bp[ct] + (size_t)128 * ldb + k0); acc2[ct] = __builtin_amdgcn_mfma_f32_16x16x32_bf16(b2, a, acc2[ct], 0, 0, 0); } }
        }
        if (wid != 0) {
#pragma unroll
            for (int ct = 0; ct < 4; ++ct) { red[((wid - 1) * NACC + ct) * 64 + lane] = acc[ct]; if (DUAL) red[((wid - 1) * NACC + 4 + ct) * 64 + lane] = acc2[ct]; }
        }
        __syncthreads();
        if (wid == 0) {
#pragma unroll
            for (int w = 0; w < 7; ++w)
#pragma unroll
                for (int ct = 0; ct < 4; ++ct) { acc[ct] += red[(w * NACC + ct) * 64 + lane]; if (DUAL) acc2[ct] += red[(w * NACC + 4 + ct) * 64 + lane]; }
#pragma unroll
            for (int ct = 0; ct < 4; ++ct) f(rt * 16 + fr, cg * 64 + ct * 16 + fq * 4, acc[ct], acc2[ct]);
        }
        __syncthreads();
    }
}
__device__ __forceinline__ void colvec(const bf16_t* WS, const bf16_t* WT, int nrows, const float* b, float* G, float* Bc) {
    int tid = threadIdx.x; asm volatile("" : "+v"(tid));
    const int lane = tid & 63, wid = tid >> 6;
    for (int r = blockIdx.x * 8 + wid; r < nrows; r += gridDim.x * 8) {
        float sg = 0.f, sb = 0.f;
#pragma unroll
        for (int h = 0; h < 2; ++h) { const int k = h * 512 + lane * 8; const u32x4 w = *(const u32x4*)(WT + (size_t)r * 1024 + k), ws_ = *(const u32x4*)(WS + (size_t)r * 1024 + k);
            const f32x4 ba = *(const f32x4*)(b + k), bb = *(const f32x4*)(b + k + 4);
            sg += ((bflo(ws_.x) + bfhi(ws_.x)) + (bflo(ws_.y) + bfhi(ws_.y))) + ((bflo(ws_.z) + bfhi(ws_.z)) + (bflo(ws_.w) + bfhi(ws_.w)));
            sb += (bflo(w.x) * ba[0] + bfhi(w.x) * ba[1]) + (bflo(w.y) * ba[2] + bfhi(w.y) * ba[3]) + (bflo(w.z) * bb[0] + bfhi(w.z) * bb[1]) + (bflo(w.w) * bb[2] + bfhi(w.w) * bb[3]); }
#pragma unroll
        for (int o = 32; o >= 1; o >>= 1) { sg += __shfl_xor(sg, o); sb += __shfl_xor(sb, o); }
        if (lane == 0) { G[r] = sg; Bc[r] = sb; }
    }
}

__device__ __forceinline__ void cvt_rows(const float* src, bf16_t* dst, size_t n8, size_t t0, size_t nth) {
    size_t i = t0;
    for (; i + 3 * nth < n8; i += 4 * nth) {
        f32x4 a[4], b[4];
#pragma unroll
        for (int q = 0; q < 4; ++q) { a[q] = *(const f32x4*)(src + (i + q * nth) * 8); b[q] = *(const f32x4*)(src + (i + q * nth) * 8 + 4); }
#pragma unroll
        for (int q = 0; q < 4; ++q) *(u32x4*)(dst + (i + q * nth) * 8) = pack8(a[q], b[q], 1.0f);
    }
    for (; i < n8; i += nth) { const f32x4 a = *(const f32x4*)(src + i * 8), b = *(const f32x4*)(src + i * 8 + 4); *(u32x4*)(dst + i * 8) = pack8(a, b, 1.0f); }
}
__device__ __forceinline__ void phase_prep(const Params& p, LAS unsigned char* lds) {
    int tid = threadIdx.x; asm volatile("" : "+v"(tid));
    const size_t t0 = (size_t)blockIdx.x * 512 + tid, nth = (size_t)gridDim.x * 512;
    unsigned char* ws = p.ws;
    { unsigned* cn = (unsigned*)(ws + W_CNT); for (size_t i = t0; i < (16 + 256) * 16; i += nth) cn[i] = 0u; }
    { f32x4* st = (f32x4*)(ws + W_ST); for (size_t i = t0; i < (size_t)3 * TT * 2 / 4; i += nth) st[i] = (f32x4){0.f, 0.f, 0.f, 0.f}; }
    LAS bf16_t* tile = (LAS bf16_t*)lds;
    const int t = tid, r = t >> 3, cs = (t & 7) * 8;
    for (int tl0 = blockIdx.x * 4; tl0 < p.total_tiles; tl0 += gridDim.x * 4) {
        int j = 0;
#pragma unroll 1
        for (int k = 1; k < NJOBS; ++k) if (tl0 >= p.jobs[k].tile_start) j = k;
        const int lt0 = tl0 - p.jobs[j].tile_start, tc_n = p.jobs[j].tiles_c, mode = p.jobs[j].mode, ldsrc = p.jobs[j].lds_, ldd = p.jobs[j].ldd;
        const float* src = p.jobs[j].src; bf16_t* dst = p.jobs[j].dst; const float* rs = p.jobs[j].rowscale;
        f32x4 a[4], b[4];
#pragma unroll
        for (int q = 0; q < 4; ++q) { const int lt = lt0 + q, tr = lt / tc_n, tc = lt % tc_n;
            const float* sp = src + (size_t)(tr * 64 + r) * ldsrc + tc * 64 + cs;
            a[q] = *(const f32x4*)sp; b[q] = *(const f32x4*)(sp + 4);
            if (rs) { const float sc_ = rs[tr * 64 + r]; a[q] *= sc_; b[q] *= sc_; } }
#pragma unroll
        for (int q = 0; q < 4; ++q) *(LAS u32x4*)(tile + q * 4608 + r * 72 + cs) = pack8(a[q], b[q], 1.0f);
        __syncthreads();
#pragma unroll
        for (int q = 0; q < 4; ++q) { const int lt = lt0 + q, tr = lt / tc_n, tc = lt % tc_n;
            unsigned short e[8];
#pragma unroll
            for (int k = 0; k < 8; ++k) e[k] = tile[q * 4608 + (cs + k) * 72 + r];
            u32x4 w; w.x = e[0] | ((unsigned)e[1] << 16); w.y = e[2] | ((unsigned)e[3] << 16); w.z = e[4] | ((unsigned)e[5] << 16); w.w = e[6] | ((unsigned)e[7] << 16);
            const int sc = tc * 64 + r;
            const int drow = mode == 0 ? sc : ((sc >> 7) * 256 + (sc & 127) + (mode == 2 ? 128 : 0));
            *(u32x4*)(dst + (size_t)drow * ldd + tr * 64 + cs) = w; }
        __syncthreads();
    }
    bf16_t* xb = (bf16_t*)(ws + W_XB);
    cvt_rows(p.in[0], xb, (size_t)TP * 1024 / 8, t0, nth);
    cvt_rows(p.in[1], xb + (size_t)TP * 1024, (size_t)TS * 1024 / 8, t0, nth);
    cvt_rows(p.in[5], (bf16_t*)(ws + W_MEMB), (size_t)2048 * 1024 / 8, t0, nth);
    cvt_rows(p.in[2], (bf16_t*)(ws + W_KB) + (size_t)8 * 256 * 1024, (size_t)16 * 256 * 1024 / 8, t0, nth);
    { bf16_t* wsb = (bf16_t*)(ws + W_WSB); const float* w_s = p.in[9];
      for (size_t i = t0; i < 65536; i += nth) { const int ii = (int)((i >> 7) & 127), jj = (int)(i & 127); const float v = ((jj >> 6) <= (ii >> 6)) ? w_s[i] : 0.f; wsb[i] = (bf16_t)(cvt_pk_bf16(v, 0.f) & 0xffff); } }
}

struct SguW { const bf16_t* WSB; const float* lng; const float* lnb; const float* b_s; const float* w_conv; };
__device__ __forceinline__ void sgu_tile(LAS unsigned char* lds, const int t, const SguW& W, const bf16_t* Zt, const bf16_t* zm2, const float* st2, bf16_t* MCt, const int h, const int nvalid, float* sv_out, float* cs_out) {
    LAS bf16_t* vT = (LAS bf16_t*)lds;
    const int lane = t & 63, wid = t >> 6, fr = lane & 15, fq = lane >> 4;
    const int j = t >> 2, cseg = (t & 3) * 32;
    u32x4 vw[4];
    if (j < nvalid) {
#pragma unroll
        for (int q = 0; q < 4; ++q) vw[q] = *(const u32x4*)(Zt + (size_t)j * NZ + 512 + h * 128 + cseg + q * 8);
    }
    const int csg = t & 15, rg = t >> 4, j0 = h * 128 + csg * 8, rl0 = rg * 4;
    u32x4 gcw[6], xiw[6], gbw[4]; f32x4 sa[2][2];
    const bool cact = rl0 < nvalid;
    if (cact) {
#pragma unroll
        for (int rr = 0; rr < 6; ++rr) { const int rl = rl0 - 2 + rr;
            const bf16_t* zp = rl >= 0 ? Zt + (size_t)rl * NZ + j0 : (zm2 ? zm2 + (size_t)(rl + 2) * NZ + j0 : nullptr);
            if (zp) { gcw[rr] = *(const u32x4*)(zp + 1536); xiw[rr] = *(const u32x4*)(zp + 2048); }
            else { gcw[rr] = (u32x4){0u, 0u, 0u, 0u}; xiw[rr] = (u32x4){0u, 0u, 0u, 0u}; } }
#pragma unroll
        for (int rr = 0; rr < 4; ++rr) gbw[rr] = *(const u32x4*)(Zt + (size_t)(rl0 + rr) * NZ + 1024 + j0);
        if (st2 && rl0 == 0) {
#pragma unroll
            for (int rr = 0; rr < 2; ++rr) { sa[rr][0] = *(const f32x4*)(st2 + rr * 512 + j0); sa[rr][1] = *(const f32x4*)(st2 + rr * 512 + j0 + 4); } }
    }
    const bool mact = wid * 16 < nvalid;
    const int mi = wid * 16 + fr;
    u32x2 uw[8];
    if (mact) {
#pragma unroll
        for (int ct = 0; ct < 8; ++ct) uw[ct] = *(const u32x2*)(Zt + (size_t)mi * NZ + h * 128 + fq * 4 + ct * 16);
    }
    if (j < nvalid) {
        float v[32];
#pragma unroll
        for (int q = 0; q < 4; ++q) { const u32x4 w = vw[q];
            v[q * 8 + 0] = bflo(w.x); v[q * 8 + 1] = bfhi(w.x); v[q * 8 + 2] = bflo(w.y); v[q * 8 + 3] = bfhi(w.y); v[q * 8 + 4] = bflo(w.z); v[q * 8 + 5] = bfhi(w.z); v[q * 8 + 6] = bflo(w.w); v[q * 8 + 7] = bfhi(w.w); }
        float s = 0.f;
#pragma unroll
        for (int k = 0; k < 32; ++k) s += v[k];
        s += __shfl_xor(s, 1); s += __shfl_xor(s, 2);
        const float mu = s * (1.0f / 128.0f); float q2 = 0.f;
#pragma unroll
        for (int k = 0; k < 32; ++k) { const float d = v[k] - mu; q2 += d * d; }
        q2 += __shfl_xor(q2, 1); q2 += __shfl_xor(q2, 2);
        const float rstd = rsqrtf(q2 * (1.0f / 128.0f) + LN_EPS);
#pragma unroll
        for (int k = 0; k < 32; ++k) v[k] = (v[k] - mu) * rstd * W.lng[h * 128 + cseg + k] + W.lnb[h * 128 + cseg + k];
        if (sv_out) { float* sv = sv_out + ((size_t)j * 4 + h) * 128 + cseg;
#pragma unroll
            for (int q = 0; q < 8; ++q) *(f32x4*)(sv + q * 4) = (f32x4){v[q * 4], v[q * 4 + 1], v[q * 4 + 2], v[q * 4 + 3]}; }
#pragma unroll
        for (int k = 0; k < 32; k += 2) { const unsigned w = cvt_pk_bf16(v[k], v[k + 1]); vT[(cseg + k) * 136 + j] = (bf16_t)(w & 0xffff); vT[(cseg + k + 1) * 136 + j] = (bf16_t)(w >> 16); }
    } else {
#pragma unroll
        for (int k = 0; k < 32; ++k) vT[(cseg + k) * 136 + j] = 0;
    }
    if (cact) {
        float w0[8], w1[8], w2[8];
#pragma unroll
        for (int q = 0; q < 2; ++q) { const f32x4 a = *(const f32x4*)(W.w_conv + j0 + q * 4), b = *(const f32x4*)(W.w_conv + 512 + j0 + q * 4), c = *(const f32x4*)(W.w_conv + 1024 + j0 + q * 4);
#pragma unroll
            for (int k = 0; k < 4; ++k) { w0[q * 4 + k] = a[k]; w1[q * 4 + k] = b[k]; w2[q * 4 + k] = c[k]; } }
        float cx[6][8];
#pragma unroll
        for (int rr = 0; rr < 6; ++rr) { const u32x4 gc = gcw[rr], xi = xiw[rr];
            cx[rr][0] = bflo(gc.x) * bflo(xi.x); cx[rr][1] = bfhi(gc.x) * bfhi(xi.x); cx[rr][2] = bflo(gc.y) * bflo(xi.y); cx[rr][3] = bfhi(gc.y) * bfhi(xi.y);
            cx[rr][4] = bflo(gc.z) * bflo(xi.z); cx[rr][5] = bfhi(gc.z) * bfhi(xi.z); cx[rr][6] = bflo(gc.w) * bflo(xi.w); cx[rr][7] = bfhi(gc.w) * bfhi(xi.w); }
        if (st2 && rl0 == 0) {
#pragma unroll
            for (int rr = 0; rr < 2; ++rr)
#pragma unroll
                for (int k = 0; k < 4; ++k) { cx[rr][k] = sa[rr][0][k]; cx[rr][4 + k] = sa[rr][1][k]; } }
#pragma unroll
        for (int rr = 0; rr < 4; ++rr) { const u32x4 gb = gbw[rr];
            const float g[8] = {bflo(gb.x), bfhi(gb.x), bflo(gb.y), bfhi(gb.y), bflo(gb.z), bfhi(gb.z), bflo(gb.w), bfhi(gb.w)}; float o[8];
#pragma unroll
            for (int k = 0; k < 8; ++k) o[k] = g[k] * (cx[rr][k] * w0[k] + cx[rr + 1][k] * w1[k] + cx[rr + 2][k] * w2[k]);
            u32x4 w; w.x = cvt_pk_bf16(o[0], o[1]); w.y = cvt_pk_bf16(o[2], o[3]); w.z = cvt_pk_bf16(o[4], o[5]); w.w = cvt_pk_bf16(o[6], o[7]);
            *(u32x4*)(MCt + (size_t)(rl0 + rr) * 1024 + 512 + j0) = w; }
        if (cs_out && rl0 + 4 == nvalid) {
#pragma unroll
            for (int q = 0; q < 2; ++q) { *(f32x4*)(cs_out + j0 + q * 4) = (f32x4){cx[4][q * 4], cx[4][q * 4 + 1], cx[4][q * 4 + 2], cx[4][q * 4 + 3]};
                *(f32x4*)(cs_out + 512 + j0 + q * 4) = (f32x4){cx[5][q * 4], cx[5][q * 4 + 1], cx[5][q * 4 + 2], cx[5][q * 4 + 3]}; }
        }
    }
    __syncthreads();
    if (mact) {
        f32x4 acc[8];
#pragma unroll
        for (int ct = 0; ct < 8; ++ct) acc[ct] = (f32x4){0.f, 0.f, 0.f, 0.f};
        const int nks = (wid < 4) ? 2 : 4;
        const bf16_t* wp = W.WSB + ((size_t)h * 128 + mi) * 128 + fq * 8;
        for (int ks = 0; ks < nks; ++ks) {
            const bf16x8 a = *(const bf16x8*)(wp + ks * 32);
#pragma unroll
            for (int ct = 0; ct < 8; ++ct) { const bf16x8 b = *(const LAS bf16x8*)(vT + (ct * 16 + fr) * 136 + ks * 32 + fq * 8); acc[ct] = __builtin_amdgcn_mfma_f32_16x16x32_bf16(b, a, acc[ct], 0, 0, 0); }
        }
        const float bs = W.b_s[h * 128 + mi];
        bf16_t* op = MCt + (size_t)mi * 1024 + h * 128 + fq * 4;
#pragma unroll
        for (int ct = 0; ct < 8; ++ct) { u32x2 o; o.x = cvt_pk_bf16(bflo(uw[ct].x) * (acc[ct][0] + bs), bfhi(uw[ct].x) * (acc[ct][1] + bs)); o.y = cvt_pk_bf16(bflo(uw[ct].y) * (acc[ct][2] + bs), bfhi(uw[ct].y) * (acc[ct][3] + bs));
            *(u32x2*)(op + ct * 16) = o; }
    }
    __syncthreads();
}

__device__ __forceinline__ void ln_apply_rows(float* X, const float* st, const float* g, const float* b, const int row0, const int nrows, const int t) {
    const int cgi = t & 255, rsel = t >> 8;
    const f32x4 gv = *(const f32x4*)(g + cgi * 4), bv = *(const f32x4*)(b + cgi * 4);
    for (int r = rsel; r < nrows; r += 8) {
        f32x4 v[4]; float mu[4], rs[4];
#pragma unroll
        for (int q = 0; q < 4; ++q) { const int row = row0 + r + 2 * q; if (r + 2 * q < nrows) { v[q] = *(const f32x4*)(X + (size_t)row * 1024 + cgi * 4); row_mu_rstd(st, row, mu[q], rs[q]); } }
#pragma unroll
        for (int q = 0; q < 4; ++q) { const int row = row0 + r + 2 * q; if (r + 2 * q < nrows) *(f32x4*)(X + (size_t)row * 1024 + cgi * 4) = (v[q] - mu[q]) * rs[q] * gv + bv; }
    }
}

__device__ __forceinline__ void sample_scores(const bf16_t* Q, const bf16_t* KB, bf16_t* P, LAS unsigned char* lds) {
    typedef float f32x2 __attribute__((ext_vector_type(2)));
    int tid = threadIdx.x; asm volatile("" : "+v"(tid));
    const int lane = tid & 63, wid = tid >> 6, fr = lane & 15, fq = lane >> 4;
    if (blockIdx.x >= 128) return;
    LAS f32x2* RMS = (LAS f32x2*)lds;
    const int task = blockIdx.x, b = task >> 3, h = (task >> 1) & 3, rt = task & 1;
    const int row = b * 32 + rt * 16 + fr;
    const bf16_t* qp = Q + (size_t)row * 1024 + h * 256 + fq * 8;
    const bf16_t* kp = KB + ((size_t)(8 + b) * 256 + wid * 32 + fr) * 1024 + h * 256 + fq * 8;
    f32x4 acc[2] = {(f32x4){0.f, 0.f, 0.f, 0.f}, (f32x4){0.f, 0.f, 0.f, 0.f}};
#pragma unroll
    for (int k = 0; k < 8; ++k) { const bf16x8 qf = *(const bf16x8*)(qp + k * 32);
#pragma unroll
        for (int mt = 0; mt < 2; ++mt) { const bf16x8 kf = *(const bf16x8*)(kp + (size_t)mt * 16 * 1024 + k * 32); acc[mt] = __builtin_amdgcn_mfma_f32_16x16x32_bf16(kf, qf, acc[mt], 0, 0, 0); } }
    float mx = fmaxf(fmaxf(fmaxf(acc[0][0], acc[0][1]), fmaxf(acc[0][2], acc[0][3])), fmaxf(fmaxf(acc[1][0], acc[1][1]), fmaxf(acc[1][2], acc[1][3])));
    mx = fmaxf(mx, __shfl_xor(mx, 16)); mx = fmaxf(mx, __shfl_xor(mx, 32));
    float sm = 0.f;
#pragma unroll
    for (int mt = 0; mt < 2; ++mt)
#pragma unroll
        for (int j = 0; j < 4; ++j) { acc[mt][j] = __builtin_amdgcn_exp2f(acc[mt][j] - mx); sm += acc[mt][j]; }
    sm += __shfl_xor(sm, 16); sm += __shfl_xor(sm, 32);
    if (fq == 0) RMS[fr * 8 + wid] = (f32x2){mx, sm};
    __syncthreads();
    float M = -3.0e38f, tot = 0.f;
#pragma unroll
    for (int w = 0; w < 8; ++w) M = fmaxf(M, RMS[fr * 8 + w].x);
#pragma unroll
    for (int w = 0; w < 8; ++w) { const f32x2 v = RMS[fr * 8 + w]; tot += v.y * __builtin_amdgcn_exp2f(v.x - M); }
    const float inv = __builtin_amdgcn_exp2f(mx - M) / tot;
    bf16_t* pp = P + (size_t)row * 1024 + h * 256 + wid * 32 + fq * 4;
#pragma unroll
    for (int mt = 0; mt < 2; ++mt) { u32x2 w; w.x = cvt_pk_bf16(acc[mt][0] * inv, acc[mt][1] * inv); w.y = cvt_pk_bf16(acc[mt][2] * inv, acc[mt][3] * inv); *(u32x2*)(pp + mt * 16) = w; }
    __syncthreads();
}

#ifndef SM_WOUT
#define SM_WOUT 1
#endif
#ifndef SM_WQ
#define SM_WQ 1
#endif
#ifndef SM_WMO
#define SM_WMO 1
#endif
#ifndef SM_GU
#define SM_GU 1
#endif
#ifndef SM_DOWN
#define SM_DOWN 1
#endif
#ifndef SM_S
#define SM_S 1
#endif
#ifndef SM_PV
#define SM_PV 1
#endif
#ifndef SM_Z
#define SM_Z 1
#endif
__device__ __forceinline__ void signal_cnt(unsigned* cnt) {
    __syncthreads();
    if (threadIdx.x == 0) { __builtin_amdgcn_fence(__ATOMIC_RELEASE, "agent"); __hip_atomic_fetch_add(cnt, 1u, __ATOMIC_RELAXED, __HIP_MEMORY_SCOPE_AGENT); }
}
__device__ __forceinline__ void wait_cnt(unsigned* cnt, unsigned n) {
    if (threadIdx.x == 0) { while (__hip_atomic_load(cnt, __ATOMIC_RELAXED, __HIP_MEMORY_SCOPE_AGENT) < n) __builtin_amdgcn_s_sleep(8); }
    __syncthreads();
    __builtin_amdgcn_fence(__ATOMIC_ACQUIRE, "agent");
}
#define SG_A(base, ld) [=](int rt, int) { return (base) + (size_t)(rt * 16) * (ld); }
#define SG_B(base, ld) [=](int, int cg_, int ct) { return (base) + (size_t)(cg_ * 64 + ct * 16) * (ld); }
#define STAT_ADD(ST, row, h) do { unsafeAtomicAdd((ST) + (size_t)(row) * 2, (h[0] + h[1]) + (h[2] + h[3])); unsafeAtomicAdd((ST) + (size_t)(row) * 2 + 1, (h[0] * h[0] + h[1] * h[1]) + (h[2] * h[2] + h[3] * h[3])); } while (0)
__device__ __forceinline__ void fill_rowstats(LAS unsigned char* lds, const float* st, const int row0, const int t) {
    typedef float f32x2 __attribute__((ext_vector_type(2)));
    if (t < 256) { float mu, rstd; row_mu_rstd(st, row0 + t, mu, rstd); *(LAS f32x2*)(lds + X_ROWS + t * 8) = (f32x2){mu, rstd}; }
    __syncthreads();
}
#define FRESH unsigned char* ws = p.ws; asm volatile("" : "+s"(ws))
#define Y (p.out)
#define XB ((bf16_t*)(ws + W_XB))
#define KB ((bf16_t*)(ws + W_KB))
#define VT ((bf16_t*)(ws + W_VT))
#define ST1 ((float*)(ws + W_ST))
#define ST2 ((float*)(ws + W_ST) + (size_t)TT * 2)
#define ST3 ((float*)(ws + W_ST) + (size_t)TT * 4)
#define GQ ((float*)(ws + W_CV))
#define BQ ((float*)(ws + W_CV) + 1024)
#define GGU ((float*)(ws + W_CV) + 2048)
#define BGU ((float*)(ws + W_CV) + 2048 + 5632)
#define g_mix (p.in[13])
#define b_mix (p.in[14])
#define g_mem (p.in[19])
#define b_mem (p.in[20])
#define CNT ((unsigned*)(ws + W_CNT))
#define ZF ((unsigned*)(ws + W_CNT) + 16 * 16)
#define sZ ((bf16_t*)(ws + S_Z))
#define sR2 ((bf16_t*)(ws + S_R2))
#define sR3 ((bf16_t*)(ws + S_R3))
#define sH ((bf16_t*)(ws + S_H))
#define sACT ((bf16_t*)(ws + S_ACT))
#define SW_INIT SguW SW; SW.WSB = (const bf16_t*)(ws + W_WSB); SW.lng = p.in[7]; SW.lnb = p.in[8]; SW.b_s = p.in[10]; SW.w_conv = p.in[11]
#define R1 ((bf16_t*)(ws + W_PR + (size_t)pm * PSZ + P_R1))
#define R2 ((bf16_t*)(ws + W_PR + (size_t)pm * PSZ + P_R2))
#define R3 ((bf16_t*)(ws + W_PR + (size_t)pm * PSZ + P_R3))
#define RH ((bf16_t*)(ws + W_PR + (size_t)pm * PSZ + P_RH))
__global__ void __launch_bounds__(512, 2) fwd_megakernel(Params p) {
    extern __shared__ __attribute__((aligned(16))) unsigned char shm[];
    LAS unsigned char* lds = (LAS unsigned char*)shm;
    cg::grid_group grid = cg::this_grid();
    const int G = (int)gridDim.x, c = (int)blockIdx.x;

    phase_prep(p, lds);
    grid.sync();
    { FRESH; OrderKV S; S.G = G; S.c = c; S.A2 = (const char*)(ws + W_MEMB); S.B2 = (const char*)(ws + W_WMKV);
      EpiZ E; E.Z = nullptr; E.outk = p.out + O_MK; E.outv = p.out + O_MV; E.kb = KB; E.vt = VT;
      gemm_phase(lds, 1024, 1024, 1024, S, E);
      const bf16_t* A = XB + (size_t)TP * 1024; const bf16_t* Bt = (const bf16_t*)(ws + W_WIN);
      small_gemm<false>(lds, 32, 40, 1024, 1024, 1024, SG_A(A, 1024), SG_B(Bt, 1024),
          [=](int r, int col, const f32x4 v, const f32x4) { u32x2 w; w.x = cvt_pk_bf16(v[0], v[1]); w.y = cvt_pk_bf16(v[2], v[3]); *(u32x2*)(sZ + (size_t)r * NZ + col) = w; });
      colvec((const bf16_t*)(ws + W_WQS), (const bf16_t*)(ws + W_WQ), 1024, b_mix, GQ, BQ);
      colvec((const bf16_t*)(ws + W_WGUS), (const bf16_t*)(ws + W_WGU), 5632, b_mem, GGU, BGU); }
    grid.sync();

    const int pm = (c & 7) * 32 + (c >> 3), bb = pm >> 5;
    int tid = threadIdx.x; asm volatile("" : "+v"(tid));
    const size_t vrow = (size_t)pm * 256;
    { FRESH; OrderChain S; S.n = 10; S.pm = pm; S.A = (const char*)(XB + vrow * 1024); S.B = (const char*)(ws + W_WIN); S.astep = 0; S.bstep = 256 * 1024 * 2;
      EpiZ E; E.Z = R1 - vrow * NZ; E.outk = nullptr; E.outv = nullptr; E.kb = nullptr; E.vt = nullptr;
      if (SM_Z) gemm_phase(lds, 1024, 1024, 1024, S, E); }
    __syncthreads();
    if (threadIdx.x == 0) { FRESH; __builtin_amdgcn_fence(__ATOMIC_RELEASE, "agent"); __hip_atomic_store(ZF + 16 * pm, 1u, __ATOMIC_RELAXED, __HIP_MEMORY_SCOPE_AGENT); }
    if (c < 64) { FRESH; SW_INIT; const int sb = c >> 2, sh = c & 3;
        sgu_tile(lds, tid, SW, sZ + (size_t)sb * 32 * NZ, nullptr, p.in[4] + (size_t)sb * 1024, sR2 + (size_t)sb * 32 * 1024, sh, 32, p.out + O_SV + (size_t)sb * 32 * 512, p.out + O_CS + (size_t)sb * 1024);
        signal_cnt(CNT + 16 * 0); }
    { FRESH; SW_INIT; const bool halo = (pm & 31) != 0;
      if (halo) wait_cnt(ZF + 16 * (pm - 1), 1u);
      const bf16_t* prevz = (const bf16_t*)(ws + W_PR + (size_t)(pm - 1) * PSZ + P_R1) + (size_t)254 * NZ;
      for (int tl = 0; tl < 8; ++tl) { const int blk = tl >> 2, h = tl & 3;
          const bf16_t* Zt = R1 + (size_t)blk * 128 * NZ;
          sgu_tile(lds, tid, SW, Zt, blk ? Zt - 2 * NZ : (halo ? prevz : nullptr), nullptr, R2 + (size_t)blk * 128 * 1024, h, 128, nullptr, (blk == 1 && (pm & 31) == 31) ? p.out + O_CP + (size_t)bb * 1024 : nullptr); } }
    { FRESH; wait_cnt(CNT + 16 * 0, 64u);
      const bf16_t* Bt = (const bf16_t*)(ws + W_WOUT); const float* xs = p.in[1];
      small_gemm<false>(lds, 32, 16, 1024, 1024, 1024, SG_A(sR2, 1024), SG_B(Bt, 1024),
          [=](int r, int col, const f32x4 v, const f32x4) { const size_t off = (size_t)r * 1024 + col; const f32x4 hh = *(const f32x4*)(xs + off) * ALPHA + v;
              u32x2 w; w.x = cvt_pk_bf16(hh[0], hh[1]); w.y = cvt_pk_bf16(hh[2], hh[3]); *(u32x2*)(sH + off) = w; const f32x4 h = (f32x4){bflo(w.x), bfhi(w.x), bflo(w.y), bfhi(w.y)}; STAT_ADD(ST1, TP + r, h); });
      signal_cnt(CNT + 16 * 1); }
    { FRESH; OrderChain S; S.n = 4; S.pm = pm; S.A = (const char*)R2; S.B = (const char*)(ws + W_WOUT); S.astep = 0; S.bstep = 256 * 1024 * 2;
      EpiRes1 E; E.base = p.in[0]; E.H = RH - vrow * 1024; E.st = ST1;
      if (SM_WOUT) gemm_phase(lds, 1024, 1024, 1024, S, E); }
    { FRESH; wait_cnt(CNT + 16 * 1, 256u);
      const bf16_t* Bt = (const bf16_t*)(ws + W_WQS);
      small_gemm<false>(lds, 32, 16, 1024, 1024, 1024, SG_A(sH, 1024), SG_B(Bt, 1024),
          [=](int r, int col, const f32x4 v, const f32x4) { float mu, rstd; row_mu_rstd(ST1, TP + r, mu, rstd); const f32x4 q = ((v - *(const f32x4*)(GQ + col) * mu) * rstd + *(const f32x4*)(BQ + col)) * QSCALE;
              u32x2 w; w.x = cvt_pk_bf16(q[0], q[1]); w.y = cvt_pk_bf16(q[2], q[3]); *(u32x2*)(sR2 + (size_t)r * 1024 + col) = w; });
      signal_cnt(CNT + 16 * 2); }
    { FRESH; OrderChain S; S.n = 4; S.pm = pm; S.A = (const char*)RH; S.B = (const char*)(ws + W_WQS); S.astep = 0; S.bstep = 256 * 1024 * 2;
      fill_rowstats(lds, ST1, pm * 256, tid);
      EpiFoldBf16 E; E.O = R2 - vrow * 1024; E.G = GQ; E.Bc = BQ; E.scale = QSCALE;
      if (SM_WQ) gemm_phase(lds, 1024, 1024, 1024, S, E); }
    { FRESH; wait_cnt(CNT + 16 * 2, 256u);
      if (c < 128) { sample_scores(sR2, KB, sR3, lds); signal_cnt(CNT + 16 * 3); } }
    { FRESH; OrderChain S; S.n = 4; S.pm = pm; S.A = (const char*)R2; S.B = (const char*)(KB + (size_t)bb * 256 * 1024); S.astep = 512; S.bstep = 512;
      EpiSoftmax E; E.P = R3 - vrow * 1024;
      if (SM_S) gemm_phase(lds, 256, 1024, 1024, S, E); }
    { FRESH; wait_cnt(CNT + 16 * 3, 128u);
      const bf16_t* vt = VT;
      small_gemm<false>(lds, 32, 16, 256, 1024, 256, [=](int rt, int cg_) { return sR3 + (size_t)(rt * 16) * 1024 + (cg_ >> 2) * 256; },
          [=](int rt, int cg_, int ct) { return vt + ((size_t)(8 + (rt >> 1)) * 1024 + cg_ * 64 + ct * 16) * 256; },
          [=](int r, int col, const f32x4 v, const f32x4) { u32x2 w; w.x = cvt_pk_bf16(v[0], v[1]); w.y = cvt_pk_bf16(v[2], v[3]); *(u32x2*)(sR2 + (size_t)r * 1024 + col) = w; });
      signal_cnt(CNT + 16 * 4); }
    { FRESH; OrderChain S; S.n = 4; S.pm = pm; S.A = (const char*)R3; S.B = (const char*)(VT + (size_t)bb * 1024 * 256); S.astep = 512; S.bstep = (size_t)256 * 256 * 2;
      EpiBf16 E; E.O = R2 - vrow * 1024; E.ldc = 1024; E.scale = 1.0f;
      if (SM_PV) gemm_phase(lds, 256, 1024, 256, S, E); }
    { FRESH; wait_cnt(CNT + 16 * 4, 256u);
      const bf16_t* Bt = (const bf16_t*)(ws + W_WMO);
      small_gemm<false>(lds, 32, 16, 1024, 1024, 1024, SG_A(sR2, 1024), SG_B(Bt, 1024),
          [=](int r, int col, const f32x4 v, const f32x4) { const size_t off = (size_t)r * 1024 + col; float mu, rstd; row_mu_rstd(ST1, TP + r, mu, rstd);
              const u32x2 hw = *(const u32x2*)(sH + off); const f32x4 h1 = (f32x4){bflo(hw.x), bfhi(hw.x), bflo(hw.y), bfhi(hw.y)};
              const f32x4 hh = ((h1 - mu) * rstd * *(const f32x4*)(g_mix + col) + *(const f32x4*)(b_mix + col)) * ALPHA + v;
              u32x2 w; w.x = cvt_pk_bf16(hh[0], hh[1]); w.y = cvt_pk_bf16(hh[2], hh[3]); *(u32x2*)(sH + off) = w; const f32x4 h = (f32x4){bflo(w.x), bfhi(w.x), bflo(w.y), bfhi(w.y)}; STAT_ADD(ST2, TP + r, h); });
      signal_cnt(CNT + 16 * 5); }
    { FRESH; OrderChain S; S.n = 4; S.pm = pm; S.A = (const char*)R2; S.B = (const char*)(ws + W_WMO); S.astep = 0; S.bstep = 256 * 1024 * 2;
      fill_rowstats(lds, ST1, pm * 256, tid);
      EpiRes2<false> E; E.H = RH - vrow * 1024; E.Yout = nullptr; E.sp = ST1; E.gp = g_mix; E.bp = b_mix; E.sn = ST2;
      if (SM_WMO) gemm_phase(lds, 1024, 1024, 1024, S, E); }
    { FRESH; wait_cnt(CNT + 16 * 5, 256u);
      const bf16_t* Bt = (const bf16_t*)(ws + W_WGUS);
      small_gemm<true>(lds, 32, 44, 1024, 1024, 1024, SG_A(sH, 1024),
          [=](int, int cg_, int ct) { const int col = cg_ * 64 + ct * 16; return Bt + (size_t)((col >> 7) * 256 + (col & 127)) * 1024; },
          [=](int r, int col, const f32x4 ga, const f32x4 ua) { float mu, rstd; row_mu_rstd(ST2, TP + r, mu, rstd); const int gc = (col >> 7) * 256 + (col & 127);
              const f32x4 g = (ga - *(const f32x4*)(GGU + gc) * mu) * rstd + *(const f32x4*)(BGU + gc), uu = (ua - *(const f32x4*)(GGU + gc + 128) * mu) * rstd + *(const f32x4*)(BGU + gc + 128); float o[4];
#pragma unroll
              for (int j = 0; j < 4; ++j) o[j] = g[j] * uu[j] * __builtin_amdgcn_rcpf(1.0f + __builtin_amdgcn_exp2f(-1.4426950408889634f * g[j]));
              u32x2 w; w.x = cvt_pk_bf16(o[0], o[1]); w.y = cvt_pk_bf16(o[2], o[3]); *(u32x2*)(sACT + (size_t)r * DFF + col) = w; });
      signal_cnt(CNT + 16 * 6); }
    { FRESH; OrderChain S; S.n = 22; S.pm = pm; S.A = (const char*)RH; S.B = (const char*)(ws + W_WGUS); S.astep = 0; S.bstep = 256 * 1024 * 2;
      fill_rowstats(lds, ST2, pm * 256, tid);
      EpiSwiglu E; E.act = R1 - vrow * DFF; E.G = GGU; E.Bc = BGU;
      if (SM_GU) gemm_phase(lds, 1024, 1024, 1024, S, E); }
    { FRESH; wait_cnt(CNT + 16 * 6, 256u);
      const bf16_t* Bt = (const bf16_t*)(ws + W_WD);
      small_gemm<false>(lds, 32, 16, DFF, DFF, DFF, SG_A(sACT, DFF), SG_B(Bt, DFF),
          [=](int r, int col, const f32x4 v, const f32x4) { const size_t off = (size_t)r * 1024 + col; float mu, rstd; row_mu_rstd(ST2, TP + r, mu, rstd);
              const u32x2 hw = *(const u32x2*)(sH + off); const f32x4 h2 = (f32x4){bflo(hw.x), bfhi(hw.x), bflo(hw.y), bfhi(hw.y)};
              const f32x4 h = ((h2 - mu) * rstd * *(const f32x4*)(g_mem + col) + *(const f32x4*)(b_mem + col)) * ALPHA + v; *(f32x4*)(Y + (size_t)TP * 1024 + off) = h; STAT_ADD(ST3, TP + r, h); });
      signal_cnt(CNT + 16 * 7); }
    { FRESH; OrderChain S; S.n = 4; S.pm = pm; S.A = (const char*)R1; S.B = (const char*)(ws + W_WD); S.astep = 0; S.bstep = (size_t)256 * DFF * 2;
      fill_rowstats(lds, ST2, pm * 256, tid);
      EpiRes2<true> E; E.H = RH - vrow * 1024; E.Yout = Y; E.sp = ST2; E.gp = g_mem; E.bp = b_mem; E.sn = ST3;
      if (SM_DOWN) gemm_phase(lds, DFF, DFF, DFF, S, E); }
    { FRESH; wait_cnt(CNT + 16 * 7, 256u);
      ln_apply_rows(Y, ST3, p.in[24], p.in[25], TP + 2 * c, 2, tid); }
    __syncthreads();
    { FRESH; ln_apply_rows(Y, ST3, p.in[24], p.in[25], pm * 256, 256, tid); }
}

extern "C" void kernel_launch(void* const* d_in, const int* in_sizes, int n_in, void* d_out, int out_size, void* d_ws, size_t ws_size, hipStream_t stream) {
    constexpr int LDS_BYTES = STAGE_BYTES + 16384;
    static int grid = 0;
    if (!grid) {
        int dev = 0, cus = 0, per_cu = 0;
        (void)hipGetDevice(&dev);
        (void)hipDeviceGetAttribute(&cus, hipDeviceAttributeMultiprocessorCount, dev);
        (void)hipFuncSetAttribute((const void*)fwd_megakernel, hipFuncAttributeMaxDynamicSharedMemorySize, LDS_BYTES);
        (void)hipOccupancyMaxActiveBlocksPerMultiprocessor(&per_cu, (const void*)fwd_megakernel, 512, LDS_BYTES);
        if (per_cu < 1) per_cu = 1;
        grid = cus * per_cu;
        if (ws_size < W_END) fprintf(stderr, "kernel_launch: workspace too small: %zu < %zu\n", ws_size, (size_t)W_END);
        fprintf(stderr, "kernel_launch: grid %d (cus %d x %d)%s\n", grid, cus, per_cu, grid == 256 ? "" : " -- this kernel needs exactly 256 workgroups");
    }
    Params p{};
    for (int i = 0; i < 26; ++i) p.in[i] = (const float*)d_in[i];
    p.out = (float*)d_out; p.ws = (unsigned char*)d_ws;
    unsigned char* ws = (unsigned char*)d_ws;
    int nj = 0, ts = 0;
    auto add = [&](const float* src, bf16_t* dst, int R, int C, int ldd, int mode, const float* rsc = nullptr) { Job& j = p.jobs[nj++]; j.src = src; j.dst = dst; j.rowscale = rsc; j.lds_ = C; j.ldd = ldd; j.tiles_c = C / 64; j.tile_start = ts; j.mode = mode; j.pad = 0; ts += (R / 64) * (C / 64); };
    add(p.in[6], (bf16_t*)(ws + W_WIN), 1024, 2560, 1024, 0);
    add(p.in[12], (bf16_t*)(ws + W_WOUT), 1024, 1024, 1024, 0);
    add(p.in[15], (bf16_t*)(ws + W_WQ), 1024, 1024, 1024, 0);
    add(p.in[16], (bf16_t*)(ws + W_WMKV), 1024, 1024, 1024, 0);
    add(p.in[17], (bf16_t*)(ws + W_WMKV) + (size_t)1024 * 1024, 1024, 1024, 1024, 0);
    add(p.in[18], (bf16_t*)(ws + W_WMO), 1024, 1024, 1024, 0);
    add(p.in[21], (bf16_t*)(ws + W_WGU), 1024, 2816, 1024, 1);
    add(p.in[22], (bf16_t*)(ws + W_WGU), 1024, 2816, 1024, 2);
    add(p.in[23], (bf16_t*)(ws + W_WD), 2816, 1024, 2816, 0);
    add(p.in[15], (bf16_t*)(ws + W_WQS), 1024, 1024, 1024, 0, p.in[13]);
    add(p.in[21], (bf16_t*)(ws + W_WGUS), 1024, 2816, 1024, 1, p.in[19]);
    add(p.in[22], (bf16_t*)(ws + W_WGUS), 1024, 2816, 1024, 2, p.in[19]);
    for (int b = 0; b < 16; ++b) add(p.in[3] + (size_t)b * 256 * 1024, (bf16_t*)(ws + W_VT) + (size_t)(8 + b) * 1024 * 256, 256, 1024, 256, 0);
    p.total_tiles = ts; p.pad = 0;
    void* args[] = {&p};
    hipError_t e = hipLaunchCooperativeKernel((const void*)fwd_megakernel, dim3(grid), dim3(512), args, LDS_BYTES, stream);
    if (e != hipSuccess) fprintf(stderr, "kernel_launch: cooperative launch failed: %s (grid %d)\n", hipGetErrorString(e), grid);
}
```

```cpp
#include <hip/hip_runtime.h>
#include <hip/hip_cooperative_groups.h>
#include <cstdio>
namespace cg = cooperative_groups;

#define LAS __attribute__((address_space(3)))
typedef unsigned short bf16_t;
typedef short bf16x8 __attribute__((ext_vector_type(8)));
typedef float f32x4 __attribute__((ext_vector_type(4)));
typedef unsigned u32x4 __attribute__((ext_vector_type(4)));
typedef unsigned u32x2 __attribute__((ext_vector_type(2)));

constexpr int TP = 65536, TS = 512, TT = TP + TS;
constexpr int DM = 1024, NZ = 2560, DFF = 2816;
constexpr float ALPHA = 1.189207115002721f;
constexpr float LN_EPS = 1e-5f;
constexpr float QSCALE = 0.0625f * 1.4426950408889634f;

constexpr size_t O_Y = 0, O_YS = 67108864, O_MK = 67633152, O_MV = 69730304, O_CP = 71827456, O_CS = 71835648, O_SV = 71852032;
constexpr size_t P_R1 = 0, P_R2 = 1441792, P_R3 = P_R2 + 524288, P_RH = P_R3 + 524288, PSZ = P_RH + 524288;
constexpr size_t W_XB = 0, W_PR = (size_t)TT * 1024 * 2, W_SM = W_PR + 256 * PSZ;
constexpr size_t S_Z = W_SM, S_R2 = S_Z + (size_t)TS * NZ * 2, S_R3 = S_R2 + (size_t)TS * 1024 * 2, S_H = S_R3 + (size_t)TS * 1024 * 2, S_ACT = S_H + (size_t)TS * 1024 * 2, W_W = S_ACT + (size_t)TS * DFF * 2;
constexpr size_t W_WIN = W_W, W_WOUT = W_WIN + 5242880, W_WQ = W_WOUT + 2097152, W_WMO = W_WQ + 2097152, W_WMKV = W_WMO + 2097152,
                 W_WGU = W_WMKV + 4194304, W_WD = W_WGU + 11534336, W_MEMB = W_WD + 5767168, W_KB = W_MEMB + 4194304, W_VT = W_KB + 12582912,
                 W_WSB = W_VT + 12582912, W_ST = W_WSB + 131072  , W_CV = W_ST + 3 * (size_t)TT * 8  ,
                 W_WQS = W_CV + 2 * 1024 * 4 + 2 * 5632 * 4  , W_WGUS = W_WQS + 2097152, W_CNT = W_WGUS + 11534336  ,
                 W_END = W_CNT + (16 + 256) * 64;

struct Job { const float* src; bf16_t* dst; const float* rowscale; int lds_, ldd, tiles_c, tile_start, mode, pad; };
constexpr int NJOBS = 28;
struct Params {
    const float* in[26];
    float* out;
    unsigned char* ws;
    Job jobs[NJOBS];
    int total_tiles, pad;
};

__device__ __forceinline__ unsigned cvt_pk_bf16(float lo, float hi) { unsigned r; asm volatile("v_cvt_pk_bf16_f32 %0, %1, %2" : "=v"(r) : "v"(lo), "v"(hi)); return r; }
__device__ __forceinline__ float bf2f(unsigned short b) { return __uint_as_float(((unsigned)b) << 16); }
__device__ __forceinline__ float bflo(unsigned w) { return __uint_as_float(w << 16); }
__device__ __forceinline__ float bfhi(unsigned w) { return __uint_as_float(w & 0xffff0000u); }

constexpr int BM = 256, BK = 64, HALF = 128, HTB = HALF * BK * 2, STAGE_BYTES = 8 * HTB, NXCD = 8, WGM = 8;
__device__ __forceinline__ int lds_byte(int r, int c) { const int st = (r >> 4) * 2 + (c >> 5), rr = r & 15, cc = c & 31, ob = rr * 64 + cc * 2; return st * 1024 + (ob ^ (((ob >> 9) & 1) << 5)); }
__device__ __forceinline__ void stage_rc(int b, int& R, int& C) { const int st = b / 1024, sb = b % 1024, swz = sb ^ (((sb >> 9) & 1) << 5); R = (st >> 1) * 16 + swz / 64; C = (st & 1) * 32 + (swz % 64) / 2; }
__device__ __forceinline__ int perm32(int rho) { const int n = rho >> 4, i = rho & 15; return 8 * (i >> 2) + 4 * n + (i & 3); }

struct Unit { int pm, pn, kind; const char* a; const char* b; };

struct OrderMap {
    int nM, nN, nwg, G, c;
    __device__ __forceinline__ void init(int nM_, int nN_, int G_, int c_) { nM = nM_; nN = nN_; nwg = nM * nN; G = G_; c = c_; }
    __device__ __forceinline__ bool map(int L, int& pm, int& pn) const {
        if (L >= nwg) return false;
        int wgid = L; { const int q = nwg / NXCD, r = nwg % NXCD, xcd = wgid % NXCD, off = wgid / NXCD; wgid = (xcd < r ? xcd * (q + 1) : r * (q + 1) + (xcd - r) * q) + off; }
        const int nig = WGM * nN, gid = wgid / nig, fm = gid * WGM, gsz = (nM - fm) < WGM ? (nM - fm) : WGM;
        pm = fm + ((wgid % nig) % gsz); pn = (wgid % nig) / gsz; return true;
    }
};
struct OrderPlain {
    OrderMap o; const char* A; const char* B; size_t astep, bstep;
    __device__ __forceinline__ bool next(int i, Unit& u) const { if (!o.map(i * o.G + o.c, u.pm, u.pn)) return false; u.kind = 0; u.a = A + (size_t)u.pm * astep; u.b = B + (size_t)u.pn * bstep; return true; }
};
struct OrderZ {
    OrderMap o; const char* A; const char* B; const char* A2; const char* B2;
    __device__ __forceinline__ bool next(int i, Unit& u) const {
        const int L = i * o.G + o.c;
        if (o.map(L, u.pm, u.pn)) { u.kind = 0; u.a = A + (size_t)u.pm * (256 * 1024 * 2); u.b = B + (size_t)u.pn * (256 * 1024 * 2); return true; }
        const int L2 = L - o.nwg; if (L2 >= 64) return false;
        u.kind = 1; u.pm = L2 >> 3; u.pn = L2 & 7; u.a = A2 + (size_t)u.pm * (256 * 1024 * 2); u.b = B2 + (size_t)u.pn * (256 * 1024 * 2); return true;
    }
};
template <int MODE> struct OrderAttn {
    OrderMap o; const char* A; const char* B;
    __device__ __forceinline__ bool next(int i, Unit& u) const {
        if (!o.map(i * o.G + o.c, u.pm, u.pn)) return false; u.kind = 0;
        u.a = A + ((size_t)u.pm * 256 * 1024 + (size_t)u.pn * 256) * 2;
        u.b = MODE == 0 ? B + ((size_t)(u.pm >> 5) * 256 * 1024 + (size_t)u.pn * 256) * 2 : B + ((size_t)(u.pm >> 5) * 1024 + (size_t)u.pn * 256) * 256 * 2;
        return true;
    }
};

struct OrderChain {
    int n, pm; const char* A; const char* B; size_t astep, bstep;
    __device__ __forceinline__ bool next(int i, Unit& u) const { if (i >= n) return false; u.pm = pm; u.pn = i; u.kind = 0; u.a = A + (size_t)i * astep; u.b = B + (size_t)i * bstep; return true; }
};
struct OrderKV {
    int G, c; const char* A2; const char* B2;
    __device__ __forceinline__ bool next(int i, Unit& u) const {
        const int L2 = i * G + c; if (L2 >= 64) return false;
        u.kind = 1; u.pm = L2 >> 3; u.pn = L2 & 7; u.a = A2 + (size_t)u.pm * (256 * 1024 * 2); u.b = B2 + (size_t)u.pn * (256 * 1024 * 2); return true;
    }
};

template <class Epi, class Sched>
__device__ __forceinline__ void gemm_phase(LAS unsigned char* lds, const int K, const int lda, const int ldb, const Sched& S, const Epi& E) {
    int tid = threadIdx.x; asm volatile("" : "+v"(tid));
    const int wid = __builtin_amdgcn_readfirstlane(tid >> 6), lane = tid & 63, wr = wid >> 2, wc = wid & 3, fr = lane & 15, fq = lane >> 4;
    const int nt = K / BK;
    unsigned voffA[2], voffB[2];
#pragma unroll
    for (int i = 0; i < 2; ++i) { int R, C; stage_rc(tid * 16 + i * 8192, R, C); const int Rb = (R & ~31) + perm32(R & 31);
        voffA[i] = (unsigned)(R * lda + C) * 2u; voffB[i] = (unsigned)(Rb * ldb + C) * 2u; }
    const size_t kstep = (size_t)(BK * 2);
    const size_t hstepA = (size_t)HALF * lda * 2, hstepB = (size_t)HALF * ldb * 2;
    const unsigned ldsw = (unsigned)wid * 1024u;
    const int aoff = lds_byte(wr * 64 + fr, fq * 8), boff = lds_byte(wc * 32 + fr, fq * 8);
#define PG8_SA(b, h) (((b) * 2 + (h)) * HTB)
#define PG8_SB(b, h) ((4 + (b) * 2 + (h)) * HTB)
#define PG8_STAGE(bufoff, gbase, voff) do { _Pragma("unroll") for (int _i = 0; _i < 2; ++_i) \
        __builtin_amdgcn_global_load_lds((const unsigned*)((const char*)(gbase) + (voff)[_i]), (LAS unsigned*)(lds + (bufoff) + ldsw + _i * 8192), 16, 0, 0); } while (0)
#define PG8_LDA(dst, b, h) do { _Pragma("unroll") for (int m = 0; m < 4; ++m) _Pragma("unroll") for (int k = 0; k < 2; ++k) dst[m][k] = *(const LAS bf16x8*)(lds + PG8_SA(b, h) + aoff + m * 2048 + k * 1024); } while (0)
#define PG8_LDB(dst, b, h) do { _Pragma("unroll") for (int n = 0; n < 2; ++n) _Pragma("unroll") for (int k = 0; k < 2; ++k) dst[n][k] = *(const LAS bf16x8*)(lds + PG8_SB(b, h) + boff + n * 2048 + k * 1024); } while (0)
#define PG8_MMA(ai, bj, At, Bt) do { __builtin_amdgcn_s_setprio(1); _Pragma("unroll") for (int m = 0; m < 4; ++m) _Pragma("unroll") for (int n = 0; n < 2; ++n) _Pragma("unroll") for (int k = 0; k < 2; ++k) \
        acc[ai][bj][m][n] = __builtin_amdgcn_mfma_f32_16x16x32_bf16(Bt[n][k], At[m][k], acc[ai][bj][m][n], 0, 0, 0); __builtin_amdgcn_s_setprio(0); } while (0)
#define PG8_WAIT_V(n) asm volatile("s_waitcnt vmcnt(" #n ")" ::: "memory")
#define PG8_WAIT_L(n) asm volatile("s_waitcnt lgkmcnt(" #n ")" ::: "memory")
#define PG8_BAR __builtin_amdgcn_s_barrier()
#define PG8_SCHED __builtin_amdgcn_sched_barrier(0)
    Unit cur, nxt; int ui = 0;
    if (!S.next(0, cur)) return;
    f32x4 acc[2][2][4][2];
#pragma unroll
    for (int a = 0; a < 2; ++a)
#pragma unroll
        for (int b = 0; b < 2; ++b)
#pragma unroll
            for (int m = 0; m < 4; ++m)
#pragma unroll
                for (int n = 0; n < 2; ++n) acc[a][b][m][n] = (f32x4){0.f, 0.f, 0.f, 0.f};
    bf16x8 At[4][2], B0[2][2], B1[2][2];
    const char* cA = cur.a; const char* cB = cur.b;
    E.prefetch(cur, lds, tid, 0);
    PG8_STAGE(PG8_SB(0, 0), cB, voffB); PG8_STAGE(PG8_SA(0, 0), cA, voffA); PG8_STAGE(PG8_SB(0, 1), cB + hstepB, voffB); PG8_STAGE(PG8_SA(0, 1), cA + hstepA, voffA);
    if (wr == 1) PG8_BAR;
    PG8_WAIT_V(4); PG8_BAR;
    PG8_STAGE(PG8_SB(1, 0), cB + kstep, voffB); PG8_STAGE(PG8_SA(1, 0), cA + kstep, voffA); PG8_STAGE(PG8_SB(1, 1), cB + hstepB + kstep, voffB);
    PG8_WAIT_V(6); PG8_BAR;
    for (;;) {
        const bool has_next = S.next(ui + 1, nxt);
        const char* nA = has_next ? nxt.a : cA; const char* nB = has_next ? nxt.b : cB;
        if (has_next) E.prefetch(nxt, lds, tid, (ui + 1) & 1);
        for (int t = 0; t < nt; t += 2) {
            const bool last = (t == nt - 2);
            const char* a1 = cA + (size_t)(t + 1) * kstep;
            const char* a2 = last ? nA : cA + (size_t)(t + 2) * kstep; const char* b2 = last ? nB : cB + (size_t)(t + 2) * kstep;
            const char* a3 = a2 + kstep; const char* b3 = b2 + kstep;
            PG8_LDB(B0, 0, 0); PG8_SCHED; PG8_LDA(At, 0, 0); PG8_STAGE(PG8_SA(1, 1), a1 + hstepA, voffA);
            PG8_WAIT_L(8); PG8_BAR; PG8_WAIT_L(0); PG8_MMA(0, 0, At, B0); PG8_BAR; PG8_SCHED;
            PG8_LDB(B1, 0, 1); PG8_STAGE(PG8_SB(0, 0), b2, voffB);
            PG8_BAR; PG8_WAIT_L(0); PG8_MMA(0, 1, At, B1); PG8_BAR;
            PG8_LDA(At, 0, 1); PG8_STAGE(PG8_SA(0, 0), a2, voffA);
            PG8_BAR; PG8_WAIT_L(0); PG8_MMA(1, 0, At, B0); PG8_BAR; PG8_SCHED;
            PG8_STAGE(PG8_SB(0, 1), b2 + hstepB, voffB);
            PG8_WAIT_V(6); PG8_BAR; PG8_MMA(1, 1, At, B1); PG8_BAR;
            PG8_LDB(B0, 1, 0); PG8_SCHED; PG8_LDA(At, 1, 0); PG8_STAGE(PG8_SA(0, 1), a2 + hstepA, voffA);
            PG8_WAIT_L(8); PG8_BAR; PG8_WAIT_L(0); PG8_MMA(0, 0, At, B0); PG8_BAR; PG8_SCHED;
            PG8_LDB(B1, 1, 1); PG8_STAGE(PG8_SB(1, 0), b3, voffB);
            PG8_BAR; PG8_WAIT_L(0); PG8_MMA(0, 1, At, B1); PG8_BAR;
            PG8_LDA(At, 1, 1); PG8_STAGE(PG8_SA(1, 0), a3, voffA);
            PG8_BAR; PG8_WAIT_L(0); PG8_MMA(1, 0, At, B0); PG8_BAR; PG8_SCHED;
            PG8_STAGE(PG8_SB(1, 1), b3 + hstepB, voffB);
            PG8_WAIT_V(6); PG8_BAR; PG8_MMA(1, 1, At, B1); PG8_BAR;
        }
        E(acc, cur, wr, wc, fr, fq, lds, ui & 1);
        if (!has_next) break;
#pragma unroll
        for (int a = 0; a < 2; ++a)
#pragma unroll
            for (int b = 0; b < 2; ++b)
#pragma unroll
                for (int m = 0; m < 4; ++m)
#pragma unroll
                    for (int n = 0; n < 2; ++n) acc[a][b][m][n] = (f32x4){0.f, 0.f, 0.f, 0.f};
        cur = nxt; cA = nA; cB = nB; ++ui;
    }
    PG8_WAIT_V(0);
    if (wr == 0) PG8_BAR;
    PG8_BAR;
#undef PG8_SA
#undef PG8_SB
#undef PG8_STAGE
#undef PG8_LDA
#undef PG8_LDB
#undef PG8_MMA
#undef PG8_WAIT_V
#undef PG8_WAIT_L
#undef PG8_SCHED
}

#define EPI_ARGS f32x4 (&acc)[2][2][4][2], const Unit& u, int wr, int wc, int fr, int fq, LAS unsigned char* lds, int pb
#define EPI_NOPF __device__ __forceinline__ void prefetch(const Unit&, LAS unsigned char*, int, int) const {}
constexpr int X_RMS = STAGE_BYTES, X_ROWS = STAGE_BYTES + 8192  , X_VEC = STAGE_BYTES + 10240  ;
#define EPI_LOOP_AM _Pragma("unroll") for (int ai = 0; ai < 2; ++ai) _Pragma("unroll") for (int m = 0; m < 4; ++m)

__device__ __forceinline__ u32x4 pack8(const f32x4 a, const f32x4 b, const float s) {
    u32x4 w; w.x = cvt_pk_bf16(a[0] * s, a[1] * s); w.y = cvt_pk_bf16(a[2] * s, a[3] * s); w.z = cvt_pk_bf16(b[0] * s, b[1] * s); w.w = cvt_pk_bf16(b[2] * s, b[3] * s); return w;
}
struct EpiBf16 {
    EPI_NOPF
    bf16_t* O; int ldc; float scale;
    __device__ __forceinline__ void operator()(EPI_ARGS) const {
        const int row0 = u.pm * BM + wr * 64 + fr, col0 = u.pn * BM + wc * 32 + 8 * fq;
        EPI_LOOP_AM { bf16_t* rowp = O + (size_t)(row0 + ai * HALF + m * 16) * ldc + col0;
#pragma unroll
            for (int bj = 0; bj < 2; ++bj) *(u32x4*)(rowp + bj * HALF) = pack8(acc[ai][bj][m][0], acc[ai][bj][m][1], scale); }
    }
};
struct EpiZ {
    EPI_NOPF
    bf16_t* Z; float* outk; float* outv; bf16_t* kb; bf16_t* vt;
    __device__ __forceinline__ void operator()(EPI_ARGS) const {
        const int row0 = u.pm * BM + wr * 64 + fr, col0 = u.pn * BM + wc * 32 + 8 * fq;
        if (u.kind == 0) {
            EPI_LOOP_AM { bf16_t* rowp = Z + (size_t)(row0 + ai * HALF + m * 16) * NZ + col0;
#pragma unroll
                for (int bj = 0; bj < 2; ++bj) __builtin_nontemporal_store(pack8(acc[ai][bj][m][0], acc[ai][bj][m][1], 1.0f), (u32x4*)(rowp + bj * HALF)); }
        } else if (u.pn < 4) {
            EPI_LOOP_AM { const size_t off = (size_t)(row0 + ai * HALF + m * 16) * 1024 + col0;
#pragma unroll
                for (int bj = 0; bj < 2; ++bj) { *(f32x4*)(outk + off + bj * HALF) = acc[ai][bj][m][0]; *(f32x4*)(outk + off + bj * HALF + 4) = acc[ai][bj][m][1];
                    *(u32x4*)(kb + off + bj * HALF) = pack8(acc[ai][bj][m][0], acc[ai][bj][m][1], 1.0f); } }
        } else {
            EPI_LOOP_AM { const int row = row0 + ai * HALF + m * 16, b = row >> 8, mm = row & 255; const size_t off = (size_t)row * 1024 + (col0 - 1024);
#pragma unroll
                for (int bj = 0; bj < 2; ++bj) { *(f32x4*)(outv + off + bj * HALF) = acc[ai][bj][m][0]; *(f32x4*)(outv + off + bj * HALF + 4) = acc[ai][bj][m][1];
                    const u32x4 w = pack8(acc[ai][bj][m][0], acc[ai][bj][m][1], 1.0f);
                    bf16_t* vp = vt + ((size_t)b * 1024 + (col0 - 1024) + bj * HALF) * 256 + mm;
                    vp[0 * 256] = (bf16_t)(w.x & 0xffff); vp[1 * 256] = (bf16_t)(w.x >> 16); vp[2 * 256] = (bf16_t)(w.y & 0xffff); vp[3 * 256] = (bf16_t)(w.y >> 16);
                    vp[4 * 256] = (bf16_t)(w.z & 0xffff); vp[5 * 256] = (bf16_t)(w.z >> 16); vp[6 * 256] = (bf16_t)(w.w & 0xffff); vp[7 * 256] = (bf16_t)(w.w >> 16); } }
        }
    }
};
__device__ __forceinline__ void row_mu_rstd(const float* st, int row, float& mu, float& rstd) {
    const float s = st[(size_t)row * 2], q = st[(size_t)row * 2 + 1]; mu = s * (1.0f / 1024.0f); rstd = rsqrtf(fmaxf(q * (1.0f / 1024.0f) - mu * mu, 0.f) + LN_EPS);
}
__device__ __forceinline__ void unpack8(const u32x4 w, f32x4& a, f32x4& b) { a = (f32x4){bflo(w.x), bfhi(w.x), bflo(w.y), bfhi(w.y)}; b = (f32x4){bflo(w.z), bfhi(w.z), bflo(w.w), bfhi(w.w)}; }
__device__ __forceinline__ void stat8(const f32x4 a, const f32x4 b, float& sm, float& sq) {
    sm = ((a[0] + a[1]) + (a[2] + a[3])) + ((b[0] + b[1]) + (b[2] + b[3]));
    sq = ((a[0] * a[0] + a[1] * a[1]) + (a[2] * a[2] + a[3] * a[3])) + ((b[0] * b[0] + b[1] * b[1]) + (b[2] * b[2] + b[3] * b[3]));
    sm += __shfl_xor(sm, 16); sm += __shfl_xor(sm, 32); sq += __shfl_xor(sq, 16); sq += __shfl_xor(sq, 32);
}
struct EpiRes1 {
    EPI_NOPF
    const float* base; bf16_t* H; float* st;
    __device__ __forceinline__ void operator()(EPI_ARGS) const {
        const int row0 = u.pm * BM + wr * 64 + fr, col0 = u.pn * BM + wc * 32 + 8 * fq;
#pragma unroll
        for (int bj = 0; bj < 2; ++bj)
#pragma unroll
            for (int ai = 0; ai < 2; ++ai) {
                f32x4 x0[4], x1[4];
#pragma unroll
                for (int m = 0; m < 4; ++m) { const size_t off = (size_t)(row0 + ai * HALF + m * 16) * 1024 + col0 + bj * HALF; x0[m] = __builtin_nontemporal_load((const f32x4*)(base + off)); x1[m] = __builtin_nontemporal_load((const f32x4*)(base + off + 4)); }
#pragma unroll
                for (int m = 0; m < 4; ++m) { const int row = row0 + ai * HALF + m * 16; const size_t off = (size_t)row * 1024 + col0 + bj * HALF;
                    const u32x4 w = pack8(x0[m] * ALPHA + acc[ai][bj][m][0], x1[m] * ALPHA + acc[ai][bj][m][1], 1.0f);
                    *(u32x4*)(H + off) = w;
                    f32x4 h0, h1; unpack8(w, h0, h1); float sm, sq; stat8(h0, h1, sm, sq);
                    if (fq == 0) { unsafeAtomicAdd(st + (size_t)row * 2, sm); unsafeAtomicAdd(st + (size_t)row * 2 + 1, sq); } }
                asm volatile("" ::: "memory"); }
    }
};
template <bool FINAL> struct EpiRes2 {
    EPI_NOPF
    bf16_t* H; float* Yout; const float* sp; const float* gp; const float* bp; float* sn;
    __device__ __forceinline__ void operator()(EPI_ARGS) const {
        const int row0 = u.pm * BM + wr * 64 + fr, col0 = u.pn * BM + wc * 32 + 8 * fq;
        typedef float f32x2 __attribute__((ext_vector_type(2)));
        float mu[2][4], rstd[2][4]; u32x4 hw[4];
#pragma unroll
        for (int m = 0; m < 4; ++m) hw[m] = *(const u32x4*)(H + (size_t)(row0 + m * 16) * 1024 + col0);
        EPI_LOOP_AM { const f32x2 t_ = *(const LAS f32x2*)(lds + X_ROWS + (ai * HALF + wr * 64 + m * 16 + fr) * 8); mu[ai][m] = t_.x; rstd[ai][m] = t_.y; }
#pragma unroll
        for (int bj = 0; bj < 2; ++bj) {
            const f32x4 gp0 = *(const f32x4*)(gp + col0 + bj * HALF), gp1 = *(const f32x4*)(gp + col0 + bj * HALF + 4), bp0 = *(const f32x4*)(bp + col0 + bj * HALF), bp1 = *(const f32x4*)(bp + col0 + bj * HALF + 4);
#pragma unroll
            for (int ai = 0; ai < 2; ++ai) {
                if (bj + ai > 0) {
#pragma unroll
                    for (int m = 0; m < 4; ++m) hw[m] = *(const u32x4*)(H + (size_t)(row0 + ai * HALF + m * 16) * 1024 + col0 + bj * HALF); }
#pragma unroll
                for (int m = 0; m < 4; ++m) { const int row = row0 + ai * HALF + m * 16; const size_t off = (size_t)row * 1024 + col0 + bj * HALF;
                    f32x4 a, b; unpack8(hw[m], a, b);
                    f32x4 h0 = ((a - mu[ai][m]) * rstd[ai][m] * gp0 + bp0) * ALPHA + acc[ai][bj][m][0], h1 = ((b - mu[ai][m]) * rstd[ai][m] * gp1 + bp1) * ALPHA + acc[ai][bj][m][1];
                    if (FINAL) { *(f32x4*)(Yout + off) = h0; *(f32x4*)(Yout + off + 4) = h1; }
                    else { const u32x4 w = pack8(h0, h1, 1.0f); *(u32x4*)(H + off) = w; unpack8(w, h0, h1); }
                    float sm, sq; stat8(h0, h1, sm, sq);
                    if (fq == 0) { unsafeAtomicAdd(sn + (size_t)row * 2, sm); unsafeAtomicAdd(sn + (size_t)row * 2 + 1, sq); } }
                asm volatile("" ::: "memory"); }
        }
    }
};
struct EpiFoldBf16 {
    bf16_t* O; const float* G; const float* Bc; float scale;
    __device__ __forceinline__ void prefetch(const Unit& u, LAS unsigned char* lds, int tid, int pb) const {
        const float* src = (tid < 256 ? G : Bc - 256) + u.pn * BM + tid;
        __builtin_amdgcn_global_load_lds((const unsigned*)src, (LAS unsigned*)(lds + X_VEC + pb * 2048 + (tid >> 6) * 256), 4, 0, 0);
    }
    __device__ __forceinline__ void operator()(EPI_ARGS) const {
        typedef float f32x2 __attribute__((ext_vector_type(2)));
        const int row0 = u.pm * BM + wr * 64 + fr, col0 = u.pn * BM + wc * 32 + 8 * fq;
        const LAS float* vec = (const LAS float*)(lds + X_VEC + pb * 2048) + wc * 32 + 8 * fq;
        f32x4 Gv[2][2], Bv[2][2];
#pragma unroll
        for (int bj = 0; bj < 2; ++bj)
#pragma unroll
            for (int n = 0; n < 2; ++n) { Gv[bj][n] = *(const LAS f32x4*)(vec + bj * HALF + 4 * n); Bv[bj][n] = *(const LAS f32x4*)(vec + 256 + bj * HALF + 4 * n); }
#pragma unroll
        for (int ai = 0; ai < 2; ++ai) {
#pragma unroll
            for (int m = 0; m < 4; ++m) { const int row = row0 + ai * HALF + m * 16;
                const f32x2 t_ = *(const LAS f32x2*)(lds + X_ROWS + (ai * HALF + wr * 64 + m * 16 + fr) * 8); const float m_ = t_.x, rs_ = t_.y;
#pragma unroll
                for (int bj = 0; bj < 2; ++bj) { const f32x4 a = (acc[ai][bj][m][0] - Gv[bj][0] * m_) * rs_ + Bv[bj][0], b = (acc[ai][bj][m][1] - Gv[bj][1] * m_) * rs_ + Bv[bj][1];
                    *(u32x4*)(O + (size_t)row * 1024 + col0 + bj * HALF) = pack8(a, b, scale); } }
            asm volatile("" ::: "memory"); }
    }
};
struct EpiSwiglu {
    bf16_t* act; const float* G; const float* Bc;
    __device__ __forceinline__ void prefetch(const Unit& u, LAS unsigned char* lds, int tid, int pb) const {
        const float* src = (tid < 256 ? G : Bc - 256) + u.pn * BM + tid;
        __builtin_amdgcn_global_load_lds((const unsigned*)src, (LAS unsigned*)(lds + X_VEC + pb * 2048 + (tid >> 6) * 256), 4, 0, 0);
    }
    __device__ __forceinline__ void operator()(EPI_ARGS) const {
        typedef float f32x2 __attribute__((ext_vector_type(2)));
        const int row0 = u.pm * BM + wr * 64 + fr, col0 = u.pn * HALF + wc * 32 + 8 * fq;
        const LAS float* vec = (const LAS float*)(lds + X_VEC + pb * 2048) + wc * 32 + 8 * fq;
        f32x4 Gg[2], Bg[2], Gu[2], Bu[2];
#pragma unroll
        for (int n = 0; n < 2; ++n) { Gg[n] = *(const LAS f32x4*)(vec + 4 * n); Bg[n] = *(const LAS f32x4*)(vec + 256 + 4 * n); Gu[n] = *(const LAS f32x4*)(vec + HALF + 4 * n); Bu[n] = *(const LAS f32x4*)(vec + 256 + HALF + 4 * n); }
#pragma unroll
        for (int ai = 0; ai < 2; ++ai) {
#pragma unroll
            for (int m = 0; m < 4; ++m) { const int row = row0 + ai * HALF + m * 16; f32x4 r[2];
                const f32x2 t_ = *(const LAS f32x2*)(lds + X_ROWS + (ai * HALF + wr * 64 + m * 16 + fr) * 8); const float m_ = t_.x, rs_ = t_.y;
#pragma unroll
                for (int n = 0; n < 2; ++n) { const f32x4 gv = (acc[ai][0][m][n] - Gg[n] * m_) * rs_ + Bg[n], uv = (acc[ai][1][m][n] - Gu[n] * m_) * rs_ + Bu[n];
#pragma unroll
                    for (int j = 0; j < 4; ++j) r[n][j] = gv[j] * uv[j] * __builtin_amdgcn_rcpf(1.0f + __builtin_amdgcn_exp2f(-1.4426950408889634f * gv[j])); }
                __builtin_nontemporal_store(pack8(r[0], r[1], 1.0f), (u32x4*)(act + (size_t)row * DFF + col0)); }
            asm volatile("" ::: "memory"); }
    }
};
struct EpiSoftmax {
    EPI_NOPF
    bf16_t* P;
    __device__ __forceinline__ void operator()(EPI_ARGS) const {
        typedef float f32x2 __attribute__((ext_vector_type(2)));
        LAS f32x2* RMS = (LAS f32x2*)(lds + STAGE_BYTES);
        EPI_LOOP_AM { float v = -3.0e38f;
#pragma unroll
            for (int bj = 0; bj < 2; ++bj)
#pragma unroll
                for (int n = 0; n < 2; ++n) { const f32x4 x = acc[ai][bj][m][n]; v = fmaxf(v, fmaxf(fmaxf(x[0], x[1]), fmaxf(x[2], x[3]))); }
            v = fmaxf(v, __shfl_xor(v, 16)); v = fmaxf(v, __shfl_xor(v, 32));
            float s = 0.f;
#pragma unroll
            for (int bj = 0; bj < 2; ++bj)
#pragma unroll
                for (int n = 0; n < 2; ++n) { f32x4 x = acc[ai][bj][m][n];
#pragma unroll
                    for (int j = 0; j < 4; ++j) x[j] = __builtin_amdgcn_exp2f(x[j] - v);
                    acc[ai][bj][m][n] = x; s += (x[0] + x[1]) + (x[2] + x[3]); }
            s += __shfl_xor(s, 16); s += __shfl_xor(s, 32);
            if (fq == 0) RMS[(ai * HALF + wr * 64 + m * 16 + fr) * 4 + wc] = (f32x2){v, s};
            asm volatile("" ::: "memory"); }
        asm volatile("s_waitcnt lgkmcnt(0)" ::: "memory"); __builtin_amdgcn_s_barrier(); asm volatile("" ::: "memory");
        const int row0 = u.pm * BM + wr * 64 + fr, col0 = u.pn * BM + wc * 32 + 8 * fq;
        EPI_LOOP_AM { const LAS f32x4* rp = (const LAS f32x4*)(RMS + (ai * HALF + wr * 64 + m * 16 + fr) * 4);
            const f32x4 p0 = rp[0], p1 = rp[1];
            const float M = fmaxf(fmaxf(p0[0], p0[2]), fmaxf(p1[0], p1[2]));
            const float tot = (p0[1] * __builtin_amdgcn_exp2f(p0[0] - M) + p0[3] * __builtin_amdgcn_exp2f(p0[2] - M)) + (p1[1] * __builtin_amdgcn_exp2f(p1[0] - M) + p1[3] * __builtin_amdgcn_exp2f(p1[2] - M));
            const float mo = wc == 0 ? p0[0] : (wc == 1 ? p0[2] : (wc == 2 ? p1[0] : p1[2]));
            const float inv = __builtin_amdgcn_exp2f(mo - M) / tot;
            bf16_t* rowp = P + (size_t)(row0 + ai * HALF + m * 16) * 1024 + col0;
#pragma unroll
            for (int bj = 0; bj < 2; ++bj) *(u32x4*)(rowp + bj * HALF) = pack8(acc[ai][bj][m][0], acc[ai][bj][m][1], inv);
            asm volatile("" ::: "memory"); }
    }
};

template <bool DUAL, class AP, class BP, class F>
__device__ __forceinline__ void small_gemm(LAS unsigned char* lds, const int nrt, const int ncg, const int K, const int lda, const int ldb, const AP aptr, const BP bptr, const F f) {
    int tid = threadIdx.x; asm volatile("" : "+v"(tid));
    const int lane = tid & 63, wid = __builtin_amdgcn_readfirstlane(tid >> 6), fr = lane & 15, fq = lane >> 4;
    const int ntask = nrt * ncg, ksl = K >> 3;
    LAS f32x4* red = (LAS f32x4*)lds;
    constexpr int NACC = DUAL ? 8 : 4;
    for (int task = blockIdx.x; task < ntask; task += gridDim.x) {
        const int rt = task % nrt, cg = task / nrt;
        const bf16_t* ap = aptr(rt, cg) + (size_t)fr * lda + fq * 8 + wid * ksl;
        const bf16_t* bp[4];
#pragma unroll
        for (int ct = 0; ct < 4; ++ct) bp[ct] = bptr(rt, cg, ct) + (size_t)fr * ldb + fq * 8 + wid * ksl;
        f32x4 acc[4], acc2[4];
#pragma unroll
        for (int ct = 0; ct < 4; ++ct) { acc[ct] = (f32x4){0.f, 0.f, 0.f, 0.f}; acc2[ct] = (f32x4){0.f, 0.f, 0.f, 0.f}; }
#pragma unroll 2
        for (int k0 = 0; k0 < ksl; k0 += 32) {
            const bf16x8 a = *(const bf16x8*)(ap + k0);
#pragma unroll
            for (int ct = 0; ct < 4; ++ct) { const bf16x8 b = *(const bf16x8*)(bp[ct] + k0); acc[ct] = __builtin_amdgcn_mfma_f32_16x16x32_bf16(b, a, acc[ct], 0, 0, 0);
                if (DUAL) { const bf16x8 b2 = *(const bf16x8*)(bp[ct] + (size_t)128 * ldb + k0); acc2[ct] = __builtin_amdgcn_mfma_f32_16x16x32_bf16(b2, a, acc2[ct], 0, 0, 0); } }
        }
        if (wid != 0) {
#pragma unroll
            for (int ct = 0; ct < 4; ++ct) { red[((wid - 1) * NACC + ct) * 64 + lane] = acc[ct]; if (DUAL) red[((wid - 1) * NACC + 4 + ct) * 64 + lane] = acc2[ct]; }
        }
        __syncthreads();
        if (wid == 0) {
#pragma unroll
            for (int w = 0; w < 7; ++w)
#pragma unroll
                for (int ct = 0; ct < 4; ++ct) { acc[ct] += red[(w * NACC + ct) * 64 + lane]; if (DUAL) acc2[ct] += red[(w * NACC + 4 + ct) * 64 + lane]; }
#pragma unroll
            for (int ct = 0; ct < 4; ++ct) f(rt * 16 + fr, cg * 64 + ct * 16 + fq * 4, acc[ct], acc2[ct]);
        }
        __syncthreads();
    }
}
__device__ __forceinline__ void colvec(const bf16_t* WS, const bf16_t* WT, int nrows, const float* b, float* G, float* Bc) {
    int tid = threadIdx.x; asm volatile("" : "+v"(tid));
    const int lane = tid & 63, wid = tid >> 6;
    for (int r = blockIdx.x * 8 + wid; r < nrows; r += gridDim.x * 8) {
        float sg = 0.f, sb = 0.f;
#pragma unroll
        for (int h = 0; h < 2; ++h) { const int k = h * 512 + lane * 8; const u32x4 w = *(const u32x4*)(WT + (size_t)r * 1024 + k), ws_ = *(const u32x4*)(WS + (size_t)r * 1024 + k);
            const f32x4 ba = *(const f32x4*)(b + k), bb = *(const f32x4*)(b + k + 4);
            sg += ((bflo(ws_.x) + bfhi(ws_.x)) + (bflo(ws_.y) + bfhi(ws_.y))) + ((bflo(ws_.z) + bfhi(ws_.z)) + (bflo(ws_.w) + bfhi(ws_.w)));
            sb += (bflo(w.x) * ba[0] + bfhi(w.x) * ba[1]) + (bflo(w.y) * ba[2] + bfhi(w.y) * ba[3]) + (bflo(w.z) * bb[0] + bfhi(w.z) * bb[1]) + (bflo(w.w) * bb[2] + bfhi(w.w) * bb[3]); }
#pragma unroll
        for (int o = 32; o >= 1; o >>= 1) { sg += __shfl_xor(sg, o); sb += __shfl_xor(sb, o); }
        if (lane == 0) { G[r] = sg; Bc[r] = sb; }
    }
}

__device__ __forceinline__ void cvt_rows(const float* src, bf16_t* dst, size_t n8, size_t t0, size_t nth) {
    size_t i = t0;
    for (; i + 3 * nth < n8; i += 4 * nth) {
        f32x4 a[4], b[4];
#pragma unroll
        for (int q = 0; q < 4; ++q) { a[q] = __builtin_nontemporal_load((const f32x4*)(src + (i + q * nth) * 8)); b[q] = __builtin_nontemporal_load((const f32x4*)(src + (i + q * nth) * 8 + 4)); }
#pragma unroll
        for (int q = 0; q < 4; ++q) *(u32x4*)(dst + (i + q * nth) * 8) = pack8(a[q], b[q], 1.0f);
    }
    for (; i < n8; i += nth) { const f32x4 a = *(const f32x4*)(src + i * 8), b = *(const f32x4*)(src + i * 8 + 4); *(u32x4*)(dst + i * 8) = pack8(a, b, 1.0f); }
}
__device__ __forceinline__ void phase_prep(const Params& p, LAS unsigned char* lds) {
    int tid = threadIdx.x; asm volatile("" : "+v"(tid));
    const size_t t0 = (size_t)blockIdx.x * 512 + tid, nth = (size_t)gridDim.x * 512;
    unsigned char* ws = p.ws;
    { unsigned* cn = (unsigned*)(ws + W_CNT); for (size_t i = t0; i < (16 + 256) * 16; i += nth) cn[i] = 0u; }
    { f32x4* st = (f32x4*)(ws + W_ST); for (size_t i = t0; i < (size_t)3 * TT * 2 / 4; i += nth) st[i] = (f32x4){0.f, 0.f, 0.f, 0.f}; }
    LAS bf16_t* tile = (LAS bf16_t*)lds;
    const int t = tid, r = t >> 3, cs = (t & 7) * 8;
    for (int tl0 = blockIdx.x * 4; tl0 < p.total_tiles; tl0 += gridDim.x * 4) {
        int j = 0;
#pragma unroll 1
        for (int k = 1; k < NJOBS; ++k) if (tl0 >= p.jobs[k].tile_start) j = k;
        const int lt0 = tl0 - p.jobs[j].tile_start, tc_n = p.jobs[j].tiles_c, mode = p.jobs[j].mode, ldsrc = p.jobs[j].lds_, ldd = p.jobs[j].ldd;
        const float* src = p.jobs[j].src; bf16_t* dst = p.jobs[j].dst; const float* rs = p.jobs[j].rowscale;
        f32x4 a[4], b[4];
#pragma unroll
        for (int q = 0; q < 4; ++q) { const int lt = lt0 + q, tr = lt / tc_n, tc = lt % tc_n;
            const float* sp = src + (size_t)(tr * 64 + r) * ldsrc + tc * 64 + cs;
            a[q] = *(const f32x4*)sp; b[q] = *(const f32x4*)(sp + 4);
            if (rs) { const float sc_ = rs[tr * 64 + r]; a[q] *= sc_; b[q] *= sc_; } }
#pragma unroll
        for (int q = 0; q < 4; ++q) *(LAS u32x4*)(tile + q * 4608 + r * 72 + cs) = pack8(a[q], b[q], 1.0f);
        __syncthreads();
#pragma unroll
        for (int q = 0; q < 4; ++q) { const int lt = lt0 + q, tr = lt / tc_n, tc = lt % tc_n;
            unsigned short e[8];
#pragma unroll
            for (int k = 0; k < 8; ++k) e[k] = tile[q * 4608 + (cs + k) * 72 + r];
            u32x4 w; w.x = e[0] | ((unsigned)e[1] << 16); w.y = e[2] | ((unsigned)e[3] << 16); w.z = e[4] | ((unsigned)e[5] << 16); w.w = e[6] | ((unsigned)e[7] << 16);
            const int sc = tc * 64 + r;
            const int drow = mode == 0 ? sc : ((sc >> 7) * 256 + (sc & 127) + (mode == 2 ? 128 : 0));
            *(u32x4*)(dst + (size_t)drow * ldd + tr * 64 + cs) = w; }
        __syncthreads();
    }
    bf16_t* xb = (bf16_t*)(ws + W_XB);
    cvt_rows(p.in[0], xb, (size_t)TP * 1024 / 8, t0, nth);
    cvt_rows(p.in[1], xb + (size_t)TP * 1024, (size_t)TS * 1024 / 8, t0, nth);
    cvt_rows(p.in[5], (bf16_t*)(ws + W_MEMB), (size_t)2048 * 1024 / 8, t0, nth);
    cvt_rows(p.in[2], (bf16_t*)(ws + W_KB) + (size_t)8 * 256 * 1024, (size_t)16 * 256 * 1024 / 8, t0, nth);
    { bf16_t* wsb = (bf16_t*)(ws + W_WSB); const float* w_s = p.in[9];
      for (size_t i = t0; i < 65536; i += nth) { const int ii = (int)((i >> 7) & 127), jj = (int)(i & 127); const float v = ((jj >> 6) <= (ii >> 6)) ? w_s[i] : 0.f; wsb[i] = (bf16_t)(cvt_pk_bf16(v, 0.f) & 0xffff); } }
}

struct SguW { const bf16_t* WSB; const float* lng; const float* lnb; const float* b_s; const float* w_conv; };
__device__ __forceinline__ void sgu_tile(LAS unsigned char* lds, const int t, const SguW& W, const bf16_t* Zt, const bf16_t* zm2, const float* st2, bf16_t* MCt, const int h, const int nvalid, float* sv_out, float* cs_out) {
    LAS bf16_t* vT = (LAS bf16_t*)lds;
    const int lane = t & 63, wid = t >> 6, fr = lane & 15, fq = lane >> 4;
    const int j = t >> 2, cseg = (t & 3) * 32;
    u32x4 vw[4];
    if (j < nvalid) {
#pragma unroll
        for (int q = 0; q < 4; ++q) vw[q] = *(const u32x4*)(Zt + (size_t)j * NZ + 512 + h * 128 + cseg + q * 8);
    }
    const int csg = t & 15, rg = t >> 4, j0 = h * 128 + csg * 8, rl0 = rg * 4;
    u32x4 gcw[6], xiw[6], gbw[4]; f32x4 sa[2][2];
    const bool cact = rl0 < nvalid;
    if (cact) {
#pragma unroll
        for (int rr = 0; rr < 6; ++rr) { const int rl = rl0 - 2 + rr;
            const bf16_t* zp = rl >= 0 ? Zt + (size_t)rl * NZ + j0 : (zm2 ? zm2 + (size_t)(rl + 2) * NZ + j0 : nullptr);
            if (zp) { gcw[rr] = *(const u32x4*)(zp + 1536); xiw[rr] = *(const u32x4*)(zp + 2048); }
            else { gcw[rr] = (u32x4){0u, 0u, 0u, 0u}; xiw[rr] = (u32x4){0u, 0u, 0u, 0u}; } }
#pragma unroll
        for (int rr = 0; rr < 4; ++rr) gbw[rr] = *(const u32x4*)(Zt + (size_t)(rl0 + rr) * NZ + 1024 + j0);
        if (st2 && rl0 == 0) {
#pragma unroll
            for (int rr = 0; rr < 2; ++rr) { sa[rr][0] = *(const f32x4*)(st2 + rr * 512 + j0); sa[rr][1] = *(const f32x4*)(st2 + rr * 512 + j0 + 4); } }
    }
    const bool mact = wid * 16 < nvalid;
    const int mi = wid * 16 + fr;
    u32x2 uw[8];
    if (mact) {
#pragma unroll
        for (int ct = 0; ct < 8; ++ct) uw[ct] = *(const u32x2*)(Zt + (size_t)mi * NZ + h * 128 + fq * 4 + ct * 16);
    }
    if (j < nvalid) {
        float v[32];
#pragma unroll
        for (int q = 0; q < 4; ++q) { const u32x4 w = vw[q];
            v[q * 8 + 0] = bflo(w.x); v[q * 8 + 1] = bfhi(w.x); v[q * 8 + 2] = bflo(w.y); v[q * 8 + 3] = bfhi(w.y); v[q * 8 + 4] = bflo(w.z); v[q * 8 + 5] = bfhi(w.z); v[q * 8 + 6] = bflo(w.w); v[q * 8 + 7] = bfhi(w.w); }
        float s = 0.f;
#pragma unroll
        for (int k = 0; k < 32; ++k) s += v[k];
        s += __shfl_xor(s, 1); s += __shfl_xor(s, 2);
        const float mu = s * (1.0f / 128.0f); float q2 = 0.f;
#pragma unroll
        for (int k = 0; k < 32; ++k) { const float d = v[k] - mu; q2 += d * d; }
        q2 += __shfl_xor(q2, 1); q2 += __shfl_xor(q2, 2);
        const float rstd = rsqrtf(q2 * (1.0f / 128.0f) + LN_EPS);
#pragma unroll
        for (int k = 0; k < 32; ++k) v[k] = (v[k] - mu) * rstd * W.lng[h * 128 + cseg + k] + W.lnb[h * 128 + cseg + k];
        if (sv_out) { float* sv = sv_out + ((size_t)j * 4 + h) * 128 + cseg;
#pragma unroll
            for (int q = 0; q < 8; ++q) *(f32x4*)(sv + q * 4) = (f32x4){v[q * 4], v[q * 4 + 1], v[q * 4 + 2], v[q * 4 + 3]}; }
#pragma unroll
        for (int k = 0; k < 32; k += 2) { const unsigned w = cvt_pk_bf16(v[k], v[k + 1]); vT[(cseg + k) * 136 + j] = (bf16_t)(w & 0xffff); vT[(cseg + k + 1) * 136 + j] = (bf16_t)(w >> 16); }
    } else {
#pragma unroll
        for (int k = 0; k < 32; ++k) vT[(cseg + k) * 136 + j] = 0;
    }
    if (cact) {
        float w0[8], w1[8], w2[8];
#pragma unroll
        for (int q = 0; q < 2; ++q) { const f32x4 a = *(const f32x4*)(W.w_conv + j0 + q * 4), b = *(const f32x4*)(W.w_conv + 512 + j0 + q * 4), c = *(const f32x4*)(W.w_conv + 1024 + j0 + q * 4);
#pragma unroll
            for (int k = 0; k < 4; ++k) { w0[q * 4 + k] = a[k]; w1[q * 4 + k] = b[k]; w2[q * 4 + k] = c[k]; } }
        float cx[6][8];
#pragma unroll
        for (int rr = 0; rr < 6; ++rr) { const u32x4 gc = gcw[rr], xi = xiw[rr];
            cx[rr][0] = bflo(gc.x) * bflo(xi.x); cx[rr][1] = bfhi(gc.x) * bfhi(xi.x); cx[rr][2] = bflo(gc.y) * bflo(xi.y); cx[rr][3] = bfhi(gc.y) * bfhi(xi.y);
            cx[rr][4] = bflo(gc.z) * bflo(xi.z); cx[rr][5] = bfhi(gc.z) * bfhi(xi.z); cx[rr][6] = bflo(gc.w) * bflo(xi.w); cx[rr][7] = bfhi(gc.w) * bfhi(xi.w); }
        if (st2 && rl0 == 0) {
#pragma unroll
            for (int rr = 0; rr < 2; ++rr)
#pragma unroll
                for (int k = 0; k < 4; ++k) { cx[rr][k] = sa[rr][0][k]; cx[rr][4 + k] = sa[rr][1][k]; } }
#pragma unroll
        for (int rr = 0; rr < 4; ++rr) { const u32x4 gb = gbw[rr];
            const float g[8] = {bflo(gb.x), bfhi(gb.x), bflo(gb.y), bfhi(gb.y), bflo(gb.z), bfhi(gb.z), bflo(gb.w), bfhi(gb.w)}; float o[8];
#pragma unroll
            for (int k = 0; k < 8; ++k) o[k] = g[k] * (cx[rr][k] * w0[k] + cx[rr + 1][k] * w1[k] + cx[rr + 2][k] * w2[k]);
            u32x4 w; w.x = cvt_pk_bf16(o[0], o[1]); w.y = cvt_pk_bf16(o[2], o[3]); w.z = cvt_pk_bf16(o[4], o[5]); w.w = cvt_pk_bf16(o[6], o[7]);
            *(u32x4*)(MCt + (size_t)(rl0 + rr) * 1024 + 512 + j0) = w; }
        if (cs_out && rl0 + 4 == nvalid) {
#pragma unroll
            for (int q = 0; q < 2; ++q) { *(f32x4*)(cs_out + j0 + q * 4) = (f32x4){cx[4][q * 4], cx[4][q * 4 + 1], cx[4][q * 4 + 2], cx[4][q * 4 + 3]};
                *(f32x4*)(cs_out + 512 + j0 + q * 4) = (f32x4){cx[5][q * 4], cx[5][q * 4 + 1], cx[5][q * 4 + 2], cx[5][q * 4 + 3]}; }
        }
    }
    __syncthreads();
    if (mact) {
        f32x4 acc[8];
#pragma unroll
        for (int ct = 0; ct < 8; ++ct) acc[ct] = (f32x4){0.f, 0.f, 0.f, 0.f};
        const int nks = (wid < 4) ? 2 : 4;
        const bf16_t* wp = W.WSB + ((size_t)h * 128 + mi) * 128 + fq * 8;
        for (int ks = 0; ks < nks; ++ks) {
            const bf16x8 a = *(const bf16x8*)(wp + ks * 32);
#pragma unroll
            for (int ct = 0; ct < 8; ++ct) { const bf16x8 b = *(const LAS bf16x8*)(vT + (ct * 16 + fr) * 136 + ks * 32 + fq * 8); acc[ct] = __builtin_amdgcn_mfma_f32_16x16x32_bf16(b, a, acc[ct], 0, 0, 0); }
        }
        const float bs = W.b_s[h * 128 + mi];
        bf16_t* op = MCt + (size_t)mi * 1024 + h * 128 + fq * 4;
#pragma unroll
        for (int ct = 0; ct < 8; ++ct) { u32x2 o; o.x = cvt_pk_bf16(bflo(uw[ct].x) * (acc[ct][0] + bs), bfhi(uw[ct].x) * (acc[ct][1] + bs)); o.y = cvt_pk_bf16(bflo(uw[ct].y) * (acc[ct][2] + bs), bfhi(uw[ct].y) * (acc[ct][3] + bs));
            *(u32x2*)(op + ct * 16) = o; }
    }
    __syncthreads();
}

__device__ __forceinline__ void ln_apply_rows(float* X, const float* st, const float* g, const float* b, const int row0, const int nrows, const int t) {
    const int cgi = t & 255, rsel = t >> 8;
    const f32x4 gv = *(const f32x4*)(g + cgi * 4), bv = *(const f32x4*)(b + cgi * 4);
    for (int r = rsel; r < nrows; r += 8) {
        f32x4 v[4]; float mu[4], rs[4];
#pragma unroll
        for (int q = 0; q < 4; ++q) { const int row = row0 + r + 2 * q; if (r + 2 * q < nrows) { v[q] = *(const f32x4*)(X + (size_t)row * 1024 + cgi * 4); row_mu_rstd(st, row, mu[q], rs[q]); } }
#pragma unroll
        for (int q = 0; q < 4; ++q) { const int row = row0 + r + 2 * q; if (r + 2 * q < nrows) __builtin_nontemporal_store((v[q] - mu[q]) * rs[q] * gv + bv, (f32x4*)(X + (size_t)row * 1024 + cgi * 4)); }
    }
}

__device__ __forceinline__ void sample_scores(const bf16_t* Q, const bf16_t* KB, bf16_t* P, LAS unsigned char* lds) {
    typedef float f32x2 __attribute__((ext_vector_type(2)));
    int tid = threadIdx.x; asm volatile("" : "+v"(tid));
    const int lane = tid & 63, wid = tid >> 6, fr = lane & 15, fq = lane >> 4;
    if (blockIdx.x >= 128) return;
    LAS f32x2* RMS = (LAS f32x2*)lds;
    const int task = blockIdx.x, b = task >> 3, h = (task >> 1) & 3, rt = task & 1;
    const int row = b * 32 + rt * 16 + fr;
    const bf16_t* qp = Q + (size_t)row * 1024 + h * 256 + fq * 8;
    const bf16_t* kp = KB + ((size_t)(8 + b) * 256 + wid * 32 + fr) * 1024 + h * 256 + fq * 8;
    f32x4 acc[2] = {(f32x4){0.f, 0.f, 0.f, 0.f}, (f32x4){0.f, 0.f, 0.f, 0.f}};
#pragma unroll
    for (int k = 0; k < 8; ++k) { const bf16x8 qf = *(const bf16x8*)(qp + k * 32);
#pragma unroll
        for (int mt = 0; mt < 2; ++mt) { const bf16x8 kf = *(const bf16x8*)(kp + (size_t)mt * 16 * 1024 + k * 32); acc[mt] = __builtin_amdgcn_mfma_f32_16x16x32_bf16(kf, qf, acc[mt], 0, 0, 0); } }
    float mx = fmaxf(fmaxf(fmaxf(acc[0][0], acc[0][1]), fmaxf(acc[0][2], acc[0][3])), fmaxf(fmaxf(acc[1][0], acc[1][1]), fmaxf(acc[1][2], acc[1][3])));
    mx = fmaxf(mx, __shfl_xor(mx, 16)); mx = fmaxf(mx, __shfl_xor(mx, 32));
    float sm = 0.f;
#pragma unroll
    for (int mt = 0; mt < 2; ++mt)
#pragma unroll
        for (int j = 0; j < 4; ++j) { acc[mt][j] = __builtin_amdgcn_exp2f(acc[mt][j] - mx); sm += acc[mt][j]; }
    sm += __shfl_xor(sm, 16); sm += __shfl_xor(sm, 32);
    if (fq == 0) RMS[fr * 8 + wid] = (f32x2){mx, sm};
    __syncthreads();
    float M = -3.0e38f, tot = 0.f;
#pragma unroll
    for (int w = 0; w < 8; ++w) M = fmaxf(M, RMS[fr * 8 + w].x);
#pragma unroll
    for (int w = 0; w < 8; ++w) { const f32x2 v = RMS[fr * 8 + w]; tot += v.y * __builtin_amdgcn_exp2f(v.x - M); }
    const float inv = __builtin_amdgcn_exp2f(mx - M) / tot;
    bf16_t* pp = P + (size_t)row * 1024 + h * 256 + wid * 32 + fq * 4;
#pragma unroll
    for (int mt = 0; mt < 2; ++mt) { u32x2 w; w.x = cvt_pk_bf16(acc[mt][0] * inv, acc[mt][1] * inv); w.y = cvt_pk_bf16(acc[mt][2] * inv, acc[mt][3] * inv); *(u32x2*)(pp + mt * 16) = w; }
    __syncthreads();
}

#ifndef SM_WOUT
#define SM_WOUT 1
#endif
#ifndef SM_WQ
#define SM_WQ 1
#endif
#ifndef SM_WMO
#define SM_WMO 1
#endif
#ifndef SM_GU
#define SM_GU 1
#endif
#ifndef SM_DOWN
#define SM_DOWN 1
#endif
#ifndef SM_S
#define SM_S 1
#endif
#ifndef SM_PV
#define SM_PV 1
#endif
#ifndef SM_Z
#define SM_Z 1
#endif
__device__ __forceinline__ void signal_cnt(unsigned* cnt) {
    __syncthreads();
    if (threadIdx.x == 0) { __builtin_amdgcn_fence(__ATOMIC_RELEASE, "agent"); __hip_atomic_fetch_add(cnt, 1u, __ATOMIC_RELAXED, __HIP_MEMORY_SCOPE_AGENT); }
}
__device__ __forceinline__ void wait_cnt(unsigned* cnt, unsigned n) {
    if (threadIdx.x == 0) { while (__hip_atomic_load(cnt, __ATOMIC_RELAXED, __HIP_MEMORY_SCOPE_AGENT) < n) __builtin_amdgcn_s_sleep(8); }
    __syncthreads();
    __builtin_amdgcn_fence(__ATOMIC_ACQUIRE, "agent");
}
#define SG_A(base, ld) [=](int rt, int) { return (base) + (size_t)(rt * 16) * (ld); }
#define SG_B(base, ld) [=](int, int cg_, int ct) { return (base) + (size_t)(cg_ * 64 + ct * 16) * (ld); }
#define STAT_ADD(ST, row, h) do { unsafeAtomicAdd((ST) + (size_t)(row) * 2, (h[0] + h[1]) + (h[2] + h[3])); unsafeAtomicAdd((ST) + (size_t)(row) * 2 + 1, (h[0] * h[0] + h[1] * h[1]) + (h[2] * h[2] + h[3] * h[3])); } while (0)
__device__ __forceinline__ void fill_rowstats(LAS unsigned char* lds, const float* st, const int row0, const int t) {
    typedef float f32x2 __attribute__((ext_vector_type(2)));
    if (t < 256) { float mu, rstd; row_mu_rstd(st, row0 + t, mu, rstd); *(LAS f32x2*)(lds + X_ROWS + t * 8) = (f32x2){mu, rstd}; }
    __syncthreads();
}
#define FRESH unsigned char* ws = p.ws; asm volatile("" : "+s"(ws))
#define Y (p.out)
#define XB ((bf16_t*)(ws + W_XB))
#define KB ((bf16_t*)(ws + W_KB))
#define VT ((bf16_t*)(ws + W_VT))
#define ST1 ((float*)(ws + W_ST))
#define ST2 ((float*)(ws + W_ST) + (size_t)TT * 2)
#define ST3 ((float*)(ws + W_ST) + (size_t)TT * 4)
#define GQ ((float*)(ws + W_CV))
#define BQ ((float*)(ws + W_CV) + 1024)
#define GGU ((float*)(ws + W_CV) + 2048)
#define BGU ((float*)(ws + W_CV) + 2048 + 5632)
#define g_mix (p.in[13])
#define b_mix (p.in[14])
#define g_mem (p.in[19])
#define b_mem (p.in[20])
#define CNT ((unsigned*)(ws + W_CNT))
#define ZF ((unsigned*)(ws + W_CNT) + 16 * 16)
#define sZ ((bf16_t*)(ws + S_Z))
#define sR2 ((bf16_t*)(ws + S_R2))
#define sR3 ((bf16_t*)(ws + S_R3))
#define sH ((bf16_t*)(ws + S_H))
#define sACT ((bf16_t*)(ws + S_ACT))
#define SW_INIT SguW SW; SW.WSB = (const bf16_t*)(ws + W_WSB); SW.lng = p.in[7]; SW.lnb = p.in[8]; SW.b_s = p.in[10]; SW.w_conv = p.in[11]
#define R1 ((bf16_t*)(ws + W_PR + (size_t)pm * PSZ + P_R1))
#define R2 ((bf16_t*)(ws + W_PR + (size_t)pm * PSZ + P_R2))
#define R3 ((bf16_t*)(ws + W_PR + (size_t)pm * PSZ + P_R3))
#define RH ((bf16_t*)(ws + W_PR + (size_t)pm * PSZ + P_RH))
__global__ void __launch_bounds__(512, 2) fwd_megakernel(Params p) {
    extern __shared__ __attribute__((aligned(16))) unsigned char shm[];
    LAS unsigned char* lds = (LAS unsigned char*)shm;
    cg::grid_group grid = cg::this_grid();
    const int G = (int)gridDim.x, c = (int)blockIdx.x;

    phase_prep(p, lds);
    grid.sync();
    { FRESH; OrderKV S; S.G = G; S.c = c; S.A2 = (const char*)(ws + W_MEMB); S.B2 = (const char*)(ws + W_WMKV);
      EpiZ E; E.Z = nullptr; E.outk = p.out + O_MK; E.outv = p.out + O_MV; E.kb = KB; E.vt = VT;
      gemm_phase(lds, 1024, 1024, 1024, S, E);
      const bf16_t* A = XB + (size_t)TP * 1024; const bf16_t* Bt = (const bf16_t*)(ws + W_WIN);
      small_gemm<false>(lds, 32, 40, 1024, 1024, 1024, SG_A(A, 1024), SG_B(Bt, 1024),
          [=](int r, int col, const f32x4 v, const f32x4) { u32x2 w; w.x = cvt_pk_bf16(v[0], v[1]); w.y = cvt_pk_bf16(v[2], v[3]); *(u32x2*)(sZ + (size_t)r * NZ + col) = w; });
      colvec((const bf16_t*)(ws + W_WQS), (const bf16_t*)(ws + W_WQ), 1024, b_mix, GQ, BQ);
      colvec((const bf16_t*)(ws + W_WGUS), (const bf16_t*)(ws + W_WGU), 5632, b_mem, GGU, BGU); }
    grid.sync();

    const int pm = (c & 7) * 32 + (c >> 3), bb = pm >> 5;
    int tid = threadIdx.x; asm volatile("" : "+v"(tid));
    const size_t vrow = (size_t)pm * 256;
    { FRESH; OrderChain S; S.n = 10; S.pm = pm; S.A = (const char*)(XB + vrow * 1024); S.B = (const char*)(ws + W_WIN); S.astep = 0; S.bstep = 256 * 1024 * 2;
      EpiZ E; E.Z = R1 - vrow * NZ; E.outk = nullptr; E.outv = nullptr; E.kb = nullptr; E.vt = nullptr;
      if (SM_Z) gemm_phase(lds, 1024, 1024, 1024, S, E); }
    __syncthreads();
    if (threadIdx.x == 0) { FRESH; __builtin_amdgcn_fence(__ATOMIC_RELEASE, "agent"); __hip_atomic_store(ZF + 16 * pm, 1u, __ATOMIC_RELAXED, __HIP_MEMORY_SCOPE_AGENT); }
    if (c < 64) { FRESH; SW_INIT; const int sb = c >> 2, sh = c & 3;
        sgu_tile(lds, tid, SW, sZ + (size_t)sb * 32 * NZ, nullptr, p.in[4] + (size_t)sb * 1024, sR2 + (size_t)sb * 32 * 1024, sh, 32, p.out + O_SV + (size_t)sb * 32 * 512, p.out + O_CS + (size_t)sb * 1024);
        signal_cnt(CNT + 16 * 0); }
    { FRESH; SW_INIT; const bool halo = (pm & 31) != 0;
      if (halo) wait_cnt(ZF + 16 * (pm - 1), 1u);
      const bf16_t* prevz = (const bf16_t*)(ws + W_PR + (size_t)(pm - 1) * PSZ + P_R1) + (size_t)254 * NZ;
      for (int tl = 0; tl < 8; ++tl) { const int blk = tl >> 2, h = tl & 3;
          const bf16_t* Zt = R1 + (size_t)blk * 128 * NZ;
          sgu_tile(lds, tid, SW, Zt, blk ? Zt - 2 * NZ : (halo ? prevz : nullptr), nullptr, R2 + (size_t)blk * 128 * 1024, h, 128, nullptr, (blk == 1 && (pm & 31) == 31) ? p.out + O_CP + (size_t)bb * 1024 : nullptr); } }
    { FRESH; wait_cnt(CNT + 16 * 0, 64u);
      const bf16_t* Bt = (const bf16_t*)(ws + W_WOUT); const float* xs = p.in[1];
      small_gemm<false>(lds, 32, 16, 1024, 1024, 1024, SG_A(sR2, 1024), SG_B(Bt, 1024),
          [=](int r, int col, const f32x4 v, const f32x4) { const size_t off = (size_t)r * 1024 + col; const f32x4 hh = *(const f32x4*)(xs + off) * ALPHA + v;
              u32x2 w; w.x = cvt_pk_bf16(hh[0], hh[1]); w.y = cvt_pk_bf16(hh[2], hh[3]); *(u32x2*)(sH + off) = w; const f32x4 h = (f32x4){bflo(w.x), bfhi(w.x), bflo(w.y), bfhi(w.y)}; STAT_ADD(ST1, TP + r, h); });
      signal_cnt(CNT + 16 * 1); }
    { FRESH; OrderChain S; S.n = 4; S.pm = pm; S.A = (const char*)R2; S.B = (const char*)(ws + W_WOUT); S.astep = 0; S.bstep = 256 * 1024 * 2;
      EpiRes1 E; E.base = p.in[0]; E.H = RH - vrow * 1024; E.st = ST1;
      if (SM_WOUT) gemm_phase(lds, 1024, 1024, 1024, S, E); }
    { FRESH; wait_cnt(CNT + 16 * 1, 256u);
      const bf16_t* Bt = (const bf16_t*)(ws + W_WQS);
      small_gemm<false>(lds, 32, 16, 1024, 1024, 1024, SG_A(sH, 1024), SG_B(Bt, 1024),
          [=](int r, int col, const f32x4 v, const f32x4) { float mu, rstd; row_mu_rstd(ST1, TP + r, mu, rstd); const f32x4 q = ((v - *(const f32x4*)(GQ + col) * mu) * rstd + *(const f32x4*)(BQ + col)) * QSCALE;
              u32x2 w; w.x = cvt_pk_bf16(q[0], q[1]); w.y = cvt_pk_bf16(q[2], q[3]); *(u32x2*)(sR2 + (size_t)r * 1024 + col) = w; });
      signal_cnt(CNT + 16 * 2); }
    { FRESH; OrderChain S; S.n = 4; S.pm = pm; S.A = (const char*)RH; S.B = (const char*)(ws + W_WQS); S.astep = 0; S.bstep = 256 * 1024 * 2;
      fill_rowstats(lds, ST1, pm * 256, tid);
      EpiFoldBf16 E; E.O = R2 - vrow * 1024; E.G = GQ; E.Bc = BQ; E.scale = QSCALE;
      if (SM_WQ) gemm_phase(lds, 1024, 1024, 1024, S, E); }
    { FRESH; wait_cnt(CNT + 16 * 2, 256u);
      if (c < 128) { sample_scores(sR2, KB, sR3, lds); signal_cnt(CNT + 16 * 3); } }
    { FRESH; OrderChain S; S.n = 4; S.pm = pm; S.A = (const char*)R2; S.B = (const char*)(KB + (size_t)bb * 256 * 1024); S.astep = 512; S.bstep = 512;
      EpiSoftmax E; E.P = R3 - vrow * 1024;
      if (SM_S) gemm_phase(lds, 256, 1024, 1024, S, E); }
    { FRESH; wait_cnt(CNT + 16 * 3, 128u);
      const bf16_t* vt = VT;
      small_gemm<false>(lds, 32, 16, 256, 1024, 256, [=](int rt, int cg_) { return sR3 + (size_t)(rt * 16) * 1024 + (cg_ >> 2) * 256; },
          [=](int rt, int cg_, int ct) { return vt + ((size_t)(8 + (rt >> 1)) * 1024 + cg_ * 64 + ct * 16) * 256; },
          [=](int r, int col, const f32x4 v, const f32x4) { u32x2 w; w.x = cvt_pk_bf16(v[0], v[1]); w.y = cvt_pk_bf16(v[2], v[3]); *(u32x2*)(sR2 + (size_t)r * 1024 + col) = w; });
      signal_cnt(CNT + 16 * 4); }
    { FRESH; OrderChain S; S.n = 4; S.pm = pm; S.A = (const char*)R3; S.B = (const char*)(VT + (size_t)bb * 1024 * 256); S.astep = 512; S.bstep = (size_t)256 * 256 * 2;
      EpiBf16 E; E.O = R2 - vrow * 1024; E.ldc = 1024; E.scale = 1.0f;
      if (SM_PV) gemm_phase(lds, 256, 1024, 256, S, E); }
    { FRESH; wait_cnt(CNT + 16 * 4, 256u);
      const bf16_t* Bt = (const bf16_t*)(ws + W_WMO);
      small_gemm<false>(lds, 32, 16, 1024, 1024, 1024, SG_A(sR2, 1024), SG_B(Bt, 1024),
          [=](int r, int col, const f32x4 v, const f32x4) { const size_t off = (size_t)r * 1024 + col; float mu, rstd; row_mu_rstd(ST1, TP + r, mu, rstd);
              const u32x2 hw = *(const u32x2*)(sH + off); const f32x4 h1 = (f32x4){bflo(hw.x), bfhi(hw.x), bflo(hw.y), bfhi(hw.y)};
              const f32x4 hh = ((h1 - mu) * rstd * *(const f32x4*)(g_mix + col) + *(const f32x4*)(b_mix + col)) * ALPHA + v;
              u32x2 w; w.x = cvt_pk_bf16(hh[0], hh[1]); w.y = cvt_pk_bf16(hh[2], hh[3]); *(u32x2*)(sH + off) = w; const f32x4 h = (f32x4){bflo(w.x), bfhi(w.x), bflo(w.y), bfhi(w.y)}; STAT_ADD(ST2, TP + r, h); });
      signal_cnt(CNT + 16 * 5); }
    { FRESH; OrderChain S; S.n = 4; S.pm = pm; S.A = (const char*)R2; S.B = (const char*)(ws + W_WMO); S.astep = 0; S.bstep = 256 * 1024 * 2;
      fill_rowstats(lds, ST1, pm * 256, tid);
      EpiRes2<false> E; E.H = RH - vrow * 1024; E.Yout = nullptr; E.sp = ST1; E.gp = g_mix; E.bp = b_mix; E.sn = ST2;
      if (SM_WMO) gemm_phase(lds, 1024, 1024, 1024, S, E); }
    { FRESH; wait_cnt(CNT + 16 * 5, 256u);
      const bf16_t* Bt = (const bf16_t*)(ws + W_WGUS);
      small_gemm<true>(lds, 32, 44, 1024, 1024, 1024, SG_A(sH, 1024),
          [=](int, int cg_, int ct) { const int col = cg_ * 64 + ct * 16; return Bt + (size_t)((col >> 7) * 256 + (col & 127)) * 1024; },
          [=](int r, int col, const f32x4 ga, const f32x4 ua) { float mu, rstd; row_mu_rstd(ST2, TP + r, mu, rstd); const int gc = (col >> 7) * 256 + (col & 127);
              const f32x4 g = (ga - *(const f32x4*)(GGU + gc) * mu) * rstd + *(const f32x4*)(BGU + gc), uu = (ua - *(const f32x4*)(GGU + gc + 128) * mu) * rstd + *(const f32x4*)(BGU + gc + 128); float o[4];
#pragma unroll
              for (int j = 0; j < 4; ++j) o[j] = g[j] * uu[j] * __builtin_amdgcn_rcpf(1.0f + __builtin_amdgcn_exp2f(-1.4426950408889634f * g[j]));
              u32x2 w; w.x = cvt_pk_bf16(o[0], o[1]); w.y = cvt_pk_bf16(o[2], o[3]); *(u32x2*)(sACT + (size_t)r * DFF + col) = w; });
      signal_cnt(CNT + 16 * 6); }
    { FRESH; OrderChain S; S.n = 22; S.pm = pm; S.A = (const char*)RH; S.B = (const char*)(ws + W_WGUS); S.astep = 0; S.bstep = 256 * 1024 * 2;
      fill_rowstats(lds, ST2, pm * 256, tid);
      EpiSwiglu E; E.act = R1 - vrow * DFF; E.G = GGU; E.Bc = BGU;
      if (SM_GU) gemm_phase(lds, 1024, 1024, 1024, S, E); }
    { FRESH; wait_cnt(CNT + 16 * 6, 256u);
      const bf16_t* Bt = (const bf16_t*)(ws + W_WD);
      small_gemm<false>(lds, 32, 16, DFF, DFF, DFF, SG_A(sACT, DFF), SG_B(Bt, DFF),
          [=](int r, int col, const f32x4 v, const f32x4) { const size_t off = (size_t)r * 1024 + col; float mu, rstd; row_mu_rstd(ST2, TP + r, mu, rstd);
              const u32x2 hw = *(const u32x2*)(sH + off); const f32x4 h2 = (f32x4){bflo(hw.x), bfhi(hw.x), bflo(hw.y), bfhi(hw.y)};
              const f32x4 h = ((h2 - mu) * rstd * *(const f32x4*)(g_mem + col) + *(const f32x4*)(b_mem + col)) * ALPHA + v; *(f32x4*)(Y + (size_t)TP * 1024 + off) = h; STAT_ADD(ST3, TP + r, h); });
      signal_cnt(CNT + 16 * 7); }
    { FRESH; OrderChain S; S.n = 4; S.pm = pm; S.A = (const char*)R1; S.B = (const char*)(ws + W_WD); S.astep = 0; S.bstep = (size_t)256 * DFF * 2;
      fill_rowstats(lds, ST2, pm * 256, tid);
      EpiRes2<true> E; E.H = RH - vrow * 1024; E.Yout = Y; E.sp = ST2; E.gp = g_mem; E.bp = b_mem; E.sn = ST3;
      if (SM_DOWN) gemm_phase(lds, DFF, DFF, DFF, S, E); }
    { FRESH; wait_cnt(CNT + 16 * 7, 256u);
      ln_apply_rows(Y, ST3, p.in[24], p.in[25], TP + 2 * c, 2, tid); }
    __syncthreads();
    { FRESH; ln_apply_rows(Y, ST3, p.in[24], p.in[25], pm * 256, 256, tid); }
}

extern "C" void kernel_launch(void* const* d_in, const int* in_sizes, int n_in, void* d_out, int out_size, void* d_ws, size_t ws_size, hipStream_t stream) {
    constexpr int LDS_BYTES = STAGE_BYTES + 16384;
    static int grid = 0;
    if (!grid) {
        int dev = 0, cus = 0, per_cu = 0;
        (void)hipGetDevice(&dev);
        (void)hipDeviceGetAttribute(&cus, hipDeviceAttributeMultiprocessorCount, dev);
        (void)hipFuncSetAttribute((const void*)fwd_megakernel, hipFuncAttributeMaxDynamicSharedMemorySize, LDS_BYTES);
        (void)hipOccupancyMaxActiveBlocksPerMultiprocessor(&per_cu, (const void*)fwd_megakernel, 512, LDS_BYTES);
        if (per_cu < 1) per_cu = 1;
        grid = cus * per_cu;
        if (ws_size < W_END) fprintf(stderr, "kernel_launch: workspace too small: %zu < %zu\n", ws_size, (size_t)W_END);
        fprintf(stderr, "kernel_launch: grid %d (cus %d x %d)%s\n", grid, cus, per_cu, grid == 256 ? "" : " -- this kernel needs exactly 256 workgroups");
    }
    Params p{};
    for (int i = 0; i < 26; ++i) p.in[i] = (const float*)d_in[i];
    p.out = (float*)d_out; p.ws = (unsigned char*)d_ws;
    unsigned char* ws = (unsigned char*)d_ws;
    int nj = 0, ts = 0;
    auto add = [&](const float* src, bf16_t* dst, int R, int C, int ldd, int mode, const float* rsc = nullptr) { Job& j = p.jobs[nj++]; j.src = src; j.dst = dst; j.rowscale = rsc; j.lds_ = C; j.ldd = ldd; j.tiles_c = C / 64; j.tile_start = ts; j.mode = mode; j.pad = 0; ts += (R / 64) * (C / 64); };
    add(p.in[6], (bf16_t*)(ws + W_WIN), 1024, 2560, 1024, 0);
    add(p.in[12], (bf16_t*)(ws + W_WOUT), 1024, 1024, 1024, 0);
    add(p.in[15], (bf16_t*)(ws + W_WQ), 1024, 1024, 1024, 0);
    add(p.in[16], (bf16_t*)(ws + W_WMKV), 1024, 1024, 1024, 0);
    add(p.in[17], (bf16_t*)(ws + W_WMKV) + (size_t)1024 * 1024, 1024, 1024, 1024, 0);
    add(p.in[18], (bf16_t*)(ws + W_WMO), 1024, 1024, 1024, 0);
    add(p.in[21], (bf16_t*)(ws + W_WGU), 1024, 2816, 1024, 1);
    add(p.in[22], (bf16_t*)(ws + W_WGU), 1024, 2816, 1024, 2);
    add(p.in[23], (bf16_t*)(ws + W_WD), 2816, 1024, 2816, 0);
    add(p.in[15], (bf16_t*)(ws + W_WQS), 1024, 1024, 1024, 0, p.in[13]);
    add(p.in[21], (bf16_t*)(ws + W_WGUS), 1024, 2816, 1024, 1, p.in[19]);
    add(p.in[22], (bf16_t*)(ws + W_WGUS), 1024, 2816, 1024, 2, p.in[19]);
    for (int b = 0; b < 16; ++b) add(p.in[3] + (size_t)b * 256 * 1024, (bf16_t*)(ws + W_VT) + (size_t)(8 + b) * 1024 * 256, 256, 1024, 256, 0);
    p.total_tiles = ts; p.pad = 0;
    void* args[] = {&p};
    hipError_t e = hipLaunchCooperativeKernel((const void*)fwd_megakernel, dim3(grid), dim3(512), args, LDS_BYTES, stream);
    if (e != hipSuccess) fprintf(stderr, "kernel_launch: cooperative launch failed: %s (grid %d)\n", hipGetErrorString(e), grid);
}
```
